# Optimizing an MI355X kernel written in HIP

```python
import jax, jax.numpy as jnp
from jax import lax
import numpy as np

D_MODEL = 1024
BATCH = 1
SEQ = 16384
DEPTH = 1
DEC_BATCH = 2
DEC_SEQ = 8192
PAST_LEN = 128

N_MEM = 256
GRID_W = 64
EPS = 1e-6

GLA_HEADS = 4
GLA_DK = 128
GLA_DV = 256
GLA_RANK = 16
GLA_TAU = 16.0
GLA_CHUNK = 64
GLA_QK = GLA_HEADS * GLA_DK
GLA_V = GLA_HEADS * GLA_DV

NAT_HEADS = 8
NAT_DH = 64
NAT_KH = 8
NAT_KW = 16
NAT_W = NAT_HEADS * NAT_DH

MEM_HEADS = 4
MEM_DH = 128
MEM_W = MEM_HEADS * MEM_DH

MIX_W = GLA_V + NAT_W + MEM_W
SPLIT_SIZES = (GLA_QK, GLA_QK, GLA_V, GLA_V, GLA_RANK, GLA_RANK,
               NAT_W, NAT_W, NAT_W, NAT_W, MEM_W, MEM_W)
IN_W = 6176

kernel_name = "hybrid_gla_natten_mem_encoder"


def rms_norm(x, g):
    xf = x.astype(jnp.float32)
    y = xf * lax.rsqrt(jnp.mean(xf * xf, axis=-1, keepdims=True) + EPS)
    return (y * g.astype(jnp.float32)).astype(x.dtype)


def _gla_scan(q, k, v, log_a):
    B, N, H, DK = q.shape
    DV = v.shape[-1]
    nc = N // GLA_CHUNK

    def to_chunks(t):
        t = t.astype(jnp.float32).reshape(B, nc, GLA_CHUNK, H, t.shape[-1])
        return jnp.moveaxis(t, 1, 0)

    qc, kc, vc, ac = to_chunks(q), to_chunks(k), to_chunks(v), to_chunks(log_a)
    causal = jnp.tril(jnp.ones((GLA_CHUNK, GLA_CHUNK), dtype=bool))[None, :, :, None, None]

    def step(S, inp):
        qi, ki, vi, ai = inp
        b = jnp.cumsum(ai, axis=1)
        diff = jnp.where(causal, b[:, :, None] - b[:, None, :], -jnp.inf)
        att = jnp.einsum('bihd,bjhd,bijhd->bhij', qi, ki, jnp.exp(diff))
        o_intra = jnp.einsum('bhij,bjhv->bihv', att, vi)
        o_inter = jnp.einsum('bihd,bhdv->bihv', qi * jnp.exp(b), S)
        b_last = b[:, -1]
        k_dec = ki * jnp.exp(b_last[:, None] - b)
        S_new = jnp.exp(b_last)[..., None] * S + jnp.einsum('bjhd,bjhv->bhdv', k_dec, vi)
        return S_new, o_intra + o_inter

    S0 = jnp.zeros((B, H, DK, DV), jnp.float32)
    _, o = lax.scan(step, S0, (qc, kc, vc, ac))
    return jnp.moveaxis(o, 0, 1).reshape(B, N, H, DV)


def gla_branch(q, k, v, g, lr_f, lr_b, w_f, b_f, w_b, b_b, norm_g):
    B, N, _ = q.shape
    log_a_f = jax.nn.log_sigmoid((lr_f @ w_f + b_f).astype(jnp.float32)) / GLA_TAU
    log_a_b = jax.nn.log_sigmoid((lr_b @ w_b + b_b).astype(jnp.float32)) / GLA_TAU
    qh = q.reshape(B, N, GLA_HEADS, GLA_DK) * (GLA_DK ** -0.5)
    kh = k.reshape(B, N, GLA_HEADS, GLA_DK)
    vh = v.reshape(B, N, GLA_HEADS, GLA_DV)
    af = log_a_f.reshape(B, N, GLA_HEADS, GLA_DK)
    ab = log_a_b.reshape(B, N, GLA_HEADS, GLA_DK)
    o_f = _gla_scan(qh, kh, vh, af)
    o_b = _gla_scan(qh[:, ::-1], kh[:, ::-1], vh[:, ::-1], ab[:, ::-1])[:, ::-1]
    o = rms_norm(o_f + o_b, norm_g)
    o = o.reshape(B, N, GLA_V) * jax.nn.silu(g.astype(jnp.float32))
    return o.astype(q.dtype)


def nat_branch(q, k, v, g, rpb):
    B, N, _ = q.shape
    rows = N // GRID_W
    kh = min(NAT_KH, rows)
    shp = (B, rows, GRID_W, NAT_HEADS, NAT_DH)
    qg = q.reshape(shp) * (NAT_DH ** -0.5)
    kg_all = k.reshape(shp)
    vg_all = v.reshape(shp)
    r = jnp.arange(rows)
    row_start = jnp.clip(r - kh // 2, 0, rows - kh)
    row_idx = row_start[:, None] + jnp.arange(kh)[None, :]
    kg = kg_all[:, row_idx]
    vg = vg_all[:, row_idx]
    c = jnp.arange(GRID_W)
    col_start = jnp.clip(c - NAT_KW // 2, 0, GRID_W - NAT_KW)
    col_in = (c[None, :] >= col_start[:, None]) & (c[None, :] < col_start[:, None] + NAT_KW)
    drow = row_idx - r[:, None] + (NAT_KH - 1)
    dcol = jnp.clip(c[None, :] - c[:, None] + (NAT_KW - 1), 0, 2 * NAT_KW - 2)
    bias = rpb[:, drow[:, None, :, None], dcol[None, :, None, :]]
    s = jnp.einsum('brqhd,brkwhd->bhrqkw', qg, kg).astype(jnp.float32)
    s = jnp.where(col_in[:, None, :], s + bias.astype(jnp.float32), -jnp.inf)
    p = jax.nn.softmax(s, axis=(-2, -1)).astype(v.dtype)
    o = jnp.einsum('bhrqkw,brkwhd->brqhd', p, vg).reshape(B, N, NAT_W)
    return (o.astype(jnp.float32) * jax.nn.silu(g.astype(jnp.float32))).astype(q.dtype)


def mem_branch(q, g, mem, mem_norm_g, w_mem_kv):
    B, N, _ = q.shape
    m = rms_norm(mem, mem_norm_g)
    mk, mv = jnp.split(m @ w_mem_kv, 2, axis=-1)
    M = mem.shape[1]
    qh = q.reshape(B, N, MEM_HEADS, MEM_DH) * (MEM_DH ** -0.5)
    mk = mk.reshape(B, M, MEM_HEADS, MEM_DH)
    mv = mv.reshape(B, M, MEM_HEADS, MEM_DH)
    s = jnp.einsum('bnhd,bmhd->bhnm', qh, mk).astype(jnp.float32)
    p = jax.nn.softmax(s, axis=-1).astype(mv.dtype)
    o = jnp.einsum('bhnm,bmhd->bnhd', p, mv).reshape(B, N, MEM_W)
    return (o.astype(jnp.float32) * jax.nn.silu(g.astype(jnp.float32))).astype(q.dtype)


def encoder_layer(x, mem, pre_g, w_in, gw_f, gb_f, gw_b, gb_b, gla_ng, rpb,
                  mem_ng, w_mem_kv, w_out, post_g):
    h = rms_norm(x, pre_g)
    proj = h @ w_in
    offs = np.cumsum(SPLIT_SIZES)[:-1].tolist()
    (gq, gk, gv, gg, glr_f, glr_b, nq, nk, nv, ng, mq, mg) = jnp.split(proj, offs, axis=-1)
    o_gla = gla_branch(gq, gk, gv, gg, glr_f, glr_b, gw_f, gb_f, gw_b, gb_b, gla_ng)
    o_nat = nat_branch(nq, nk, nv, ng, rpb)
    o_mem = mem_branch(mq, mg, mem, mem_ng, w_mem_kv)
    mixed = jnp.concatenate([o_gla, o_nat, o_mem], axis=-1)
    out = mixed @ w_out
    return (x + rms_norm(out, post_g)).astype(x.dtype)


def run_trunk(x, mem, pre_norm_g, w_in, gla_w_fwd, gla_b_fwd, gla_w_bwd, gla_b_bwd,
              gla_norm_g, nat_rpb, mem_norm_g, w_mem_kv, w_out, post_norm_g):
    for l in range(DEPTH):
        x = encoder_layer(x, mem, pre_norm_g[l], w_in[l], gla_w_fwd[l], gla_b_fwd[l],
                          gla_w_bwd[l], gla_b_bwd[l], gla_norm_g[l], nat_rpb[l],
                          mem_norm_g[l], w_mem_kv[l], w_out[l], post_norm_g[l])
    return x


def setup_inputs(seed: int = 0) -> dict:
    key = jax.random.key(seed)
    ks = jax.random.split(key, 20)
    f32 = jnp.float32
    nrm = lambda k, s, sc: jax.random.normal(k, s, f32) * sc
    return {
        "x_prompt": nrm(ks[0], (BATCH, SEQ, D_MODEL), 1.0),
        "x_sample": nrm(ks[1], (DEC_BATCH, DEC_SEQ, D_MODEL), 1.0),
        "mem_prompt": nrm(ks[2], (BATCH, N_MEM, D_MODEL), 1.0),
        "mem_sample": nrm(ks[3], (DEC_BATCH, N_MEM, D_MODEL), 1.0),
        "pre_norm_g": 1.0 + nrm(ks[4], (DEPTH, D_MODEL), 0.01),
        "w_in": nrm(ks[5], (DEPTH, D_MODEL, IN_W), D_MODEL ** -0.5),
        "gla_w_fwd": nrm(ks[6], (DEPTH, GLA_RANK, GLA_QK), GLA_RANK ** -0.5),
        "gla_b_fwd": nrm(ks[7], (DEPTH, GLA_QK), 0.1),
        "gla_w_bwd": nrm(ks[8], (DEPTH, GLA_RANK, GLA_QK), GLA_RANK ** -0.5),
        "gla_b_bwd": nrm(ks[9], (DEPTH, GLA_QK), 0.1),
        "gla_norm_g": 1.0 + nrm(ks[10], (DEPTH, GLA_DV), 0.01),
        "nat_rpb": nrm(ks[11], (DEPTH, NAT_HEADS, 2 * NAT_KH - 1, 2 * NAT_KW - 1), 0.02),
        "mem_norm_g": 1.0 + nrm(ks[12], (DEPTH, D_MODEL), 0.01),
        "w_mem_kv": nrm(ks[13], (DEPTH, D_MODEL, 2 * MEM_W), D_MODEL ** -0.5),
        "w_out": nrm(ks[14], (DEPTH, MIX_W, D_MODEL), MIX_W ** -0.5),
        "post_norm_g": 1.0 + nrm(ks[15], (DEPTH, D_MODEL), 0.01),
    }


def reference(x_prompt, x_sample, mem_prompt, mem_sample, pre_norm_g, w_in,
              gla_w_fwd, gla_b_fwd, gla_w_bwd, gla_b_bwd, gla_norm_g, nat_rpb,
              mem_norm_g, w_mem_kv, w_out, post_norm_g):
    y_prompt = run_trunk(x_prompt, mem_prompt, pre_norm_g, w_in, gla_w_fwd, gla_b_fwd,
                         gla_w_bwd, gla_b_bwd, gla_norm_g, nat_rpb, mem_norm_g,
                         w_mem_kv, w_out, post_norm_g)
    y_sample = run_trunk(x_sample, mem_sample, pre_norm_g, w_in, gla_w_fwd, gla_b_fwd,
                         gla_w_bwd, gla_b_bwd, gla_norm_g, nat_rpb, mem_norm_g,
                         w_mem_kv, w_out, post_norm_g)
    return (y_prompt, y_sample)
```

```cpp
#include <hip/hip_runtime.h>
#include <hip/hip_cooperative_groups.h>
#include <cstdio>
namespace cg = cooperative_groups;

typedef unsigned short u16;
typedef __attribute__((ext_vector_type(8))) short bf16x8;
typedef __attribute__((ext_vector_type(4))) short bf16x4;
typedef __attribute__((ext_vector_type(16))) float f32x16;
typedef __attribute__((ext_vector_type(4))) float f32x4;
typedef __attribute__((ext_vector_type(4))) unsigned u32x4;
typedef __attribute__((ext_vector_type(2))) unsigned u32x2;

#define DI __device__ __forceinline__
#define MFMA32(a, b, c) __builtin_amdgcn_mfma_f32_32x32x16_bf16((a), (b), (c), 0, 0, 0)

static constexpr int NT = 512;
static constexpr int SL = 16384;
static constexpr int DM = 1024;
static constexpr int LDP = 6272;
static constexpr int C_GQ = 0, C_GK = 512, C_GV = 1024, C_GG = 2048, C_NQ = 3072, C_NK = 3584, C_NV = 4096,
                     C_NG = 4608, C_MQ = 5120, C_MG = 5632, C_LRF = 6144, C_LRB = 6160;
static constexpr int SMEM_BYTES = 144 * 1024;
#ifndef PH
#define PH 0xFFF
#endif
#ifndef DUP
#define DUP 0
#endif
#ifndef REP_P1
#define REP_P1 1
#endif

struct Params {
  const float* x[2];
  const float* mem[2];
  const float *pre_g, *w_in, *gw_f, *gb_f, *gw_b, *gb_b, *gla_ng, *rpb, *mem_ng, *w_kv, *w_out, *post_g;
  float* out;
  u16 *proj, *wt_in, *wt_kv, *wt_out, *hm, *mkv;
  float *U, *Dlog;
  unsigned* bar;
  int dry; int rep_p1; int use_cg_sync; int pad3_;
};

typedef __attribute__((ext_vector_type(2))) __bf16 bf16v2;
typedef __attribute__((ext_vector_type(2))) float f32x2;
DI unsigned pack2(float a, float b) { f32x2 v; v[0] = a; v[1] = b; return __builtin_bit_cast(unsigned, __builtin_convertvector(v, bf16v2)); }
DI u16 f2bf(float x) { return (u16)(pack2(x, 0.f) & 0xffffu); }
DI float bf2f(u16 v) { return __uint_as_float(((unsigned)v) << 16); }
DI int otid() { int t = (int)threadIdx.x; asm volatile("" : "+v"(t)); return t; }
DI int crow(int reg, int h) { return (reg & 3) + 8 * (reg >> 2) + 4 * h; }
DI float silu(float g) { return g / (1.f + __expf(-g)); }
DI float wave_sum(float v) {
#pragma unroll
  for (int o = 32; o > 0; o >>= 1) v += __shfl_xor(v, o, 64);
  return v;
}
template <int S> DI bf16x8 pack8(const f32x16& x) {
  u32x4 p;
  p[0] = pack2(x[8 * S + 0], x[8 * S + 1]); p[1] = pack2(x[8 * S + 2], x[8 * S + 3]);
  p[2] = pack2(x[8 * S + 4], x[8 * S + 5]); p[3] = pack2(x[8 * S + 6], x[8 * S + 7]);
  return __builtin_bit_cast(bf16x8, p);
}
DI bf16x8 ld_perm(const u16* rowbase, int s, int h) {
  bf16x4 lo = *(const bf16x4*)(rowbase + 16 * s + 4 * h);
  bf16x4 hi = *(const bf16x4*)(rowbase + 16 * s + 8 + 4 * h);
  return __builtin_shufflevector(lo, hi, 0, 1, 2, 3, 4, 5, 6, 7);
}


DI bf16x8 gather_nat(const u16* colp, int ld, int k0) {
  u32x4 r;
#pragma unroll
  for (int j = 0; j < 4; ++j) r[j] = (unsigned)colp[(k0 + 2 * j) * ld] | ((unsigned)colp[(k0 + 2 * j + 1) * ld] << 16);
  return __builtin_bit_cast(bf16x8, r);
}
DI bf16x8 gather_perm(const u16* colp, int ld, int kb, int s, int h) {
  const int k0 = kb + 16 * s + 4 * h;
  u32x4 r;
  r[0] = (unsigned)colp[(k0 + 0) * ld] | ((unsigned)colp[(k0 + 1) * ld] << 16);
  r[1] = (unsigned)colp[(k0 + 2) * ld] | ((unsigned)colp[(k0 + 3) * ld] << 16);
  r[2] = (unsigned)colp[(k0 + 8) * ld] | ((unsigned)colp[(k0 + 9) * ld] << 16);
  r[3] = (unsigned)colp[(k0 + 10) * ld] | ((unsigned)colp[(k0 + 11) * ld] << 16);
  return __builtin_bit_cast(bf16x8, r);
}

typedef __attribute__((ext_vector_type(4))) short s16x4;
#define LDS3 __attribute__((address_space(3)))
DI bf16x8 tr_frag(const u16* tile, int ld, int col0, int r0, int r1, int lane) {
  const int q = (lane & 15) >> 2, pcol = col0 + 16 * ((lane >> 4) & 1) + 4 * (lane & 3);
  const s16x4 lo = __builtin_amdgcn_ds_read_tr16_b64_v4i16((LDS3 s16x4*)(tile + (r0 + q) * ld + pcol));
  const s16x4 hi = __builtin_amdgcn_ds_read_tr16_b64_v4i16((LDS3 s16x4*)(tile + (r1 + q) * ld + pcol));
  return __builtin_shufflevector(lo, hi, 0, 1, 2, 3, 4, 5, 6, 7);
}

#define XB_TMO      128
#define XB_XCNT(j)  (256  + 64 * (j))
#define XB_XSUB(j)  (1280 + 64 * (j))
#define XB_XGEN(j)  (2304 + 64 * (j))
#define XB_TOP      3328
#define XB_TOPGEN   3392
#define XCD_BAR_WORDS 3456
#define XB_SPIN_CAP (1u << 18)
#define LAS __attribute__((address_space(3)))
DI unsigned xb_ld(unsigned* p)              { return __hip_atomic_load(p, __ATOMIC_RELAXED, __HIP_MEMORY_SCOPE_AGENT); }
DI unsigned xb_add(unsigned* p, unsigned v) { return __hip_atomic_fetch_add(p, v, __ATOMIC_RELAXED, __HIP_MEMORY_SCOPE_AGENT); }
DI unsigned xb_xcc_id() { return (unsigned)__builtin_amdgcn_s_getreg((3 << 11) | 20) & 0xFu; }
#define XB_SPIN(cond, bar) do { unsigned _sp = 0; while (cond) { __builtin_amdgcn_s_sleep(1); \
    if ((++_sp & 255u) == 0u) { if (xb_ld(&(bar)[XB_TMO])) break; if (_sp > XB_SPIN_CAP) { atomicAdd(&(bar)[XB_TMO], 1u); break; } } } } while (0)
struct XcdBarrier { unsigned* bar; unsigned x; volatile LAS unsigned* st; };
DI XcdBarrier xcd_barrier_post(unsigned* bar, volatile LAS unsigned* st) {
  XcdBarrier b; b.bar = bar; b.x = xb_xcc_id(); b.st = st;
  if (threadIdx.x == 0) (void)xb_add(&bar[XB_XCNT(b.x)], 1u);
  return b;
}
DI void xcd_barrier_complete(unsigned* bar, unsigned x, unsigned& nloc, unsigned& nx) {
  const unsigned G = gridDim.x * gridDim.y * gridDim.z;
  unsigned sum, cnt, mine, sp = 0u;
  for (;;) {
    sum = 0u; cnt = 0u; mine = 0u;
#pragma unroll
    for (unsigned j = 0; j < 16; ++j) { const unsigned c = xb_ld(&bar[XB_XCNT(j)]); sum += c; cnt += (c > 0u) ? 1u : 0u; mine = (j == x) ? c : mine; }
    if (sum == G) break;
    __builtin_amdgcn_s_sleep(1);
    if ((++sp & 255u) == 0u) { if (xb_ld(&bar[XB_TMO])) break; if (sp > XB_SPIN_CAP) { atomicAdd(&bar[XB_TMO], 1u); break; } }
  }
  nloc = mine > 0u ? mine : 1u; nx = cnt > 0u ? cnt : 1u;
}
DI void xcd_barrier(const XcdBarrier& b) {
  asm volatile("s_waitcnt vmcnt(0)" ::: "memory");
  __syncthreads();
  if (threadIdx.x == 0) {
    unsigned* bar = b.bar;
    __builtin_amdgcn_s_waitcnt(0);
    unsigned nloc = b.st[0], nx = b.st[1];
    if (nloc == 0u) { xcd_barrier_complete(bar, b.x, nloc, nx); b.st[0] = nloc; b.st[1] = nx; }
    const unsigned old = xb_add(&bar[XB_XSUB(b.x)], 1u);
    const unsigned gen = old / nloc;
    if (old + 1u == (gen + 1u) * nloc) {
      __builtin_amdgcn_fence(__ATOMIC_RELEASE, "agent");
      asm volatile("s_waitcnt vmcnt(0)" ::: "memory");
      const unsigned og = xb_add(&bar[XB_TOP], 1u);
      const unsigned tg = og / nx;
      if (og + 1u == (tg + 1u) * nx) xb_add(&bar[XB_TOPGEN], 1u);
      else XB_SPIN(xb_ld(&bar[XB_TOPGEN]) == tg, bar);
      __builtin_amdgcn_fence(__ATOMIC_ACQUIRE, "agent");
      xb_add(&bar[XB_XGEN(b.x)], 1u);
      asm volatile("s_waitcnt vmcnt(0)" ::: "memory");
    } else {
      XB_SPIN(xb_ld(&bar[XB_XGEN(b.x)]) == gen, bar);
      __builtin_amdgcn_fence(__ATOMIC_ACQUIRE, "agent");
      asm volatile("s_waitcnt vmcnt(0)" ::: "memory");
    }
  }
  __syncthreads();
}

DI void prep_rows(const Params& p, int row_lo, int row_hi, int wi, int wc) {
  const int lane = otid() & 63, w = otid() >> 6;
  const int nw = wc * (NT / 64);
  for (int row0 = row_lo + (wi * (NT / 64) + w) * 4; row0 < row_hi; row0 += nw * 4) {
    f32x4 v[4][4];
    const float* g = (row0 < 2 * SL) ? p.pre_g : p.mem_ng;
#pragma unroll
    for (int u = 0; u < 4; ++u) {
      const int row = row0 + u;
      const float* src;
      if (row < 2 * SL) { int s = row >> 14, r = row & (SL - 1); src = p.x[s] + (size_t)r * DM; }
      else { int r = row - 2 * SL; src = (r < 256) ? p.mem[0] + (size_t)r * DM : p.mem[1] + (size_t)(r - 256) * DM; }
#pragma unroll
      for (int i = 0; i < 4; ++i) v[u][i] = *(const f32x4*)(src + (i * 64 + lane) * 4);
    }
    f32x4 gg[4];
#pragma unroll
    for (int i = 0; i < 4; ++i) gg[i] = *(const f32x4*)(g + (i * 64 + lane) * 4);
#pragma unroll
    for (int u = 0; u < 4; ++u) {
      const int row = row0 + u;
      u16* dst;
      if (row < 2 * SL) { int s = row >> 14, r = row & (SL - 1); dst = (u16*)(p.out + (size_t)s * SL * DM) + (size_t)r * DM; }
      else dst = p.hm + (size_t)(row - 2 * SL) * DM;
      float ss = 0.f;
#pragma unroll
      for (int i = 0; i < 4; ++i) ss += v[u][i][0] * v[u][i][0] + v[u][i][1] * v[u][i][1] + v[u][i][2] * v[u][i][2] + v[u][i][3] * v[u][i][3];
      ss = wave_sum(ss);
      const float rstd = rsqrtf(ss * (1.f / DM) + 1e-6f);
#pragma unroll
      for (int i = 0; i < 4; ++i) {
        u32x2 o; o[0] = pack2(v[u][i][0] * rstd * gg[i][0], v[u][i][1] * rstd * gg[i][1]);
        o[1] = pack2(v[u][i][2] * rstd * gg[i][2], v[u][i][3] * rstd * gg[i][3]);
        *(u32x2*)(dst + (i * 64 + lane) * 4) = o;
      }
    }
  }
}

template <int MODE>
DI void transpose_tile(const float* __restrict__ src, int N, int K, u16* __restrict__ dst, int n0, int k0, char* smem) {
  float* tile = (float*)smem;
  const int tid = otid();
  {
    const int nn = tid & 127, kb = tid >> 7;
    const int np = n0 + nn;
    int sc; float scale = 1.f; bool valid = true;
    if (MODE == 0) {
      if (np < 3072) { sc = np; if (np < 512) scale = 0.08838834764831845f; }
      else if (np < 6144) { sc = np + 32; if (np < C_NK) scale = 0.125f; else if (np >= C_MQ && np < C_MG) scale = 0.08838834764831845f; }
      else if (np < 6176) { sc = np - 3072; }
      else { sc = 0; valid = false; }
    } else sc = np;
    float v[16];
#pragma unroll
    for (int i = 0; i < 16; ++i) v[i] = valid ? src[(size_t)(k0 + kb + 4 * i) * N + sc] : 0.f;
#pragma unroll
    for (int i = 0; i < 16; ++i) tile[(kb + 4 * i) * 129 + nn] = v[i] * scale;
  }
  __syncthreads();
  {
    const int kk = tid & 63, nb = tid >> 6;
#pragma unroll
    for (int i = 0; i < 16; ++i) {
      int nn = nb + 8 * i;
      dst[(size_t)(n0 + nn) * K + k0 + kk] = f2bf(tile[kk * 129 + nn]);
    }
  }
  __syncthreads();
}

DI void phase0(const Params& p, char* smem) {
  for (int t = blockIdx.x; t < 49 * 16; t += gridDim.x) transpose_tile<0>(p.w_in, 6176, 1024, p.wt_in, (t % 49) * 128, (t / 49) * 64, smem);
  for (int t = blockIdx.x; t < 8 * 16; t += gridDim.x) transpose_tile<1>(p.w_kv, 1024, 1024, p.wt_kv, (t % 8) * 128, (t / 8) * 64, smem);
  prep_rows(p, 0, SL, blockIdx.x, gridDim.x);
  prep_rows(p, 2 * SL, 2 * SL + 768, blockIdx.x, gridDim.x);
}

DI void prep_wout(const Params& p, char* smem, int wi, int wc) {
  for (int t = wi; t < 8 * 32; t += wc) transpose_tile<1>(p.w_out, 1024, 2048, p.wt_out, (t % 8) * 128, (t / 8) * 64, smem);
}

template <int MODE>
DI void gemm_tile(const u16* __restrict__ A, int lda, const u16* __restrict__ Bt, int K, int m0, int n0, void* outp, char* smem) {
  u16* As0 = (u16*)smem;
  u16* Bs0 = As0 + 256 * 72;
  u16* As1 = Bs0 + 128 * 72;
  u16* Bs1 = As1 + 256 * 72;
  const int tid = otid(), lane = tid & 63, w = tid >> 6, h = lane >> 5, l31 = lane & 31;
  const int wm = w >> 1, wn = w & 1;
  const int lrow = tid >> 3, kc = tid & 7;
  f32x16 acc[2][2];
#pragma unroll
  for (int i = 0; i < 2; ++i)
#pragma unroll
    for (int j = 0; j < 2; ++j)
#pragma unroll
      for (int r = 0; r < 16; ++r) acc[i][j][r] = 0.f;
  u32x4 ra0[4], rb0[2], ra1[4], rb1[2];
  const int nk = K / 64;
  auto acol = [&](int k0) -> int {
    if (MODE == 2) return (k0 < 1024) ? (C_GG + k0) : ((k0 < 1536) ? (C_NG + k0 - 1024) : (C_MG + k0 - 1536));
    return k0;
  };
  const u16* Abase = A + (size_t)(m0 + lrow) * lda + kc * 8;
  const u16* Bbase = Bt + (size_t)(n0 + lrow) * K + kc * 8;
  auto gload = [&](int kt, u32x4* ra, u32x4* rb) {
    const int k0 = kt * 64; const int ac = acol(k0);
#pragma unroll
    for (int i = 0; i < 4; ++i) ra[i] = *(const u32x4*)(Abase + (size_t)(64 * i) * lda + ac);
#pragma unroll
    for (int i = 0; i < 2; ++i) rb[i] = *(const u32x4*)(Bbase + (size_t)(64 * i) * K + k0);
  };
  auto lstore = [&](u16* As, u16* Bs, const u32x4* ra, const u32x4* rb) {
#pragma unroll
    for (int i = 0; i < 4; ++i) *(u32x4*)(As + (lrow + 64 * i) * 72 + kc * 8) = ra[i];
#pragma unroll
    for (int i = 0; i < 2; ++i) *(u32x4*)(Bs + (lrow + 64 * i) * 72 + kc * 8) = rb[i];
  };
  auto step = [&](const u16* AsC, const u16* BsC, u16* AsN, u16* BsN, const u32x4* ra, const u32x4* rb, bool do_store) {
#pragma unroll
    for (int ks = 0; ks < 4; ++ks) {
      bf16x8 a[2], b[2];
#pragma unroll
      for (int i = 0; i < 2; ++i) a[i] = *(const bf16x8*)(AsC + (64 * wm + 32 * i + l31) * 72 + 16 * ks + 8 * h);
#pragma unroll
      for (int j = 0; j < 2; ++j) b[j] = *(const bf16x8*)(BsC + (64 * wn + 32 * j + l31) * 72 + 16 * ks + 8 * h);
#pragma unroll
      for (int i = 0; i < 2; ++i)
#pragma unroll
        for (int j = 0; j < 2; ++j) acc[i][j] = MFMA32(a[i], b[j], acc[i][j]);
      if (do_store) {
        if (ks == 0) { *(u32x4*)(AsN + (lrow) * 72 + kc * 8) = ra[0]; *(u32x4*)(AsN + (lrow + 64) * 72 + kc * 8) = ra[1]; }
        if (ks == 1) { *(u32x4*)(AsN + (lrow + 128) * 72 + kc * 8) = ra[2]; *(u32x4*)(AsN + (lrow + 192) * 72 + kc * 8) = ra[3]; }
        if (ks == 2) { *(u32x4*)(BsN + (lrow) * 72 + kc * 8) = rb[0]; *(u32x4*)(BsN + (lrow + 64) * 72 + kc * 8) = rb[1]; }
      }
    }
  };
  gload(0, ra0, rb0); gload(1, ra1, rb1);
  lstore(As0, Bs0, ra0, rb0);
  gload(2, ra0, rb0);
  __syncthreads();
  for (int kt = 0; kt < nk; kt += 2) {
    step(As0, Bs0, As1, Bs1, ra1, rb1, true);
    if (kt + 3 < nk) gload(kt + 3, ra1, rb1);
    __syncthreads();
    step(As1, Bs1, As0, Bs0, ra0, rb0, kt + 2 < nk);
    if (kt + 4 < nk) gload(kt + 4, ra0, rb0);
    __syncthreads();
  }
#pragma unroll
  for (int i = 0; i < 2; ++i)
#pragma unroll
    for (int j = 0; j < 2; ++j)
#pragma unroll
      for (int r = 0; r < 16; ++r) {
        const int row = m0 + 64 * wm + 32 * i + crow(r, h);
        const int col = n0 + 64 * wn + 32 * j + l31;
        if (MODE == 0) ((u16*)outp)[(size_t)row * LDP + col] = f2bf(acc[i][j][r]);
        else if (MODE == 1) ((u16*)outp)[(size_t)row * 1024 + col] = f2bf(acc[i][j][r]);
        else ((float*)outp)[(size_t)row * 1024 + col] = acc[i][j][r];
      }
}

template <int MODE>
DI void gemm_tile_big(const u16* __restrict__ A, int lda, const u16* __restrict__ Bt, int K, int m0, int n0, void* outp, char* smem) {
  u16* As0 = (u16*)smem;
  u16* Bs0 = As0 + 256 * 72;
  u16* As1 = Bs0 + 256 * 72;
  u16* Bs1 = As1 + 256 * 72;
  const int tid = otid(), lane = tid & 63, w = tid >> 6, h = lane >> 5, l31 = lane & 31;
  const int wm = w >> 2, wn = w & 3;
  const int lrow = tid >> 3, kc = tid & 7;
  f32x16 acc[4][2];
#pragma unroll
  for (int i = 0; i < 4; ++i)
#pragma unroll
    for (int j = 0; j < 2; ++j)
#pragma unroll
      for (int r = 0; r < 16; ++r) acc[i][j][r] = 0.f;
  u32x4 ra[4], rb[4];
  const int nk = K / 64;
  auto acol = [&](int k0) -> int {
    if (MODE == 2) return (k0 < 1024) ? (C_GG + k0) : ((k0 < 1536) ? (C_NG + k0 - 1024) : (C_MG + k0 - 1536));
    return k0;
  };
  const u16* Abase = A + (size_t)(m0 + lrow) * lda + kc * 8;
  const u16* Bbase = Bt + (size_t)(n0 + lrow) * K + kc * 8;
  auto gload = [&](int kt) {
    const int k0 = kt * 64; const int ac = acol(k0);
#pragma unroll
    for (int i = 0; i < 4; ++i) ra[i] = *(const u32x4*)(Abase + (size_t)(64 * i) * lda + ac);
#pragma unroll
    for (int i = 0; i < 4; ++i) rb[i] = *(const u32x4*)(Bbase + (size_t)(64 * i) * K + k0);
  };
  auto step = [&](const u16* AsC, const u16* BsC, u16* AsN, u16* BsN, bool do_store) {
#pragma unroll
    for (int ks = 0; ks < 4; ++ks) {
      bf16x8 a[4], b[2];
#pragma unroll
      for (int i = 0; i < 4; ++i) a[i] = *(const bf16x8*)(AsC + (128 * wm + 32 * i + l31) * 72 + 16 * ks + 8 * h);
#pragma unroll
      for (int j = 0; j < 2; ++j) b[j] = *(const bf16x8*)(BsC + (64 * wn + 32 * j + l31) * 72 + 16 * ks + 8 * h);
#pragma unroll
      for (int i = 0; i < 4; ++i)
#pragma unroll
        for (int j = 0; j < 2; ++j) acc[i][j] = MFMA32(a[i], b[j], acc[i][j]);
      if (do_store && ks == 2) {
#pragma unroll
        for (int i = 0; i < 4; ++i) *(u32x4*)(AsN + (lrow + 64 * i) * 72 + kc * 8) = ra[i];
      }
      if (do_store && ks == 3) {
#pragma unroll
        for (int i = 0; i < 4; ++i) *(u32x4*)(BsN + (lrow + 64 * i) * 72 + kc * 8) = rb[i];
      }
    }
  };
  gload(0);
#pragma unroll
  for (int i = 0; i < 4; ++i) { *(u32x4*)(As0 + (lrow + 64 * i) * 72 + kc * 8) = ra[i]; *(u32x4*)(Bs0 + (lrow + 64 * i) * 72 + kc * 8) = rb[i]; }
  gload(1);
  __syncthreads();
  for (int kt = 0; kt < nk; kt += 2) {
    step(As0, Bs0, As1, Bs1, true);
    if (kt + 2 < nk) gload(kt + 2);
    __syncthreads();
    step(As1, Bs1, As0, Bs0, kt + 2 < nk);
    if (kt + 3 < nk) gload(kt + 3);
    __syncthreads();
  }
#pragma unroll
  for (int i = 0; i < 4; ++i)
#pragma unroll
    for (int j = 0; j < 2; ++j)
#pragma unroll
      for (int r = 0; r < 16; ++r) {
        const int row = m0 + 128 * wm + 32 * i + crow(r, h);
        const int col = n0 + 64 * wn + 32 * j + l31;
        if (MODE == 0) ((u16*)outp)[(size_t)row * LDP + col] = f2bf(acc[i][j][r]);
        else ((u16*)outp)[(size_t)row * 2048 + col] = f2bf(acc[i][j][r]);
      }
}

template <bool PASS_C>
DI void gla_item(const Params& p, int slice, int item, char* smem, bool dry = false) {
  u16* Qs = (u16*)smem;
  u16* Ks = Qs + 64 * 136;
  u16* KTs = Ks + 64 * 136;
  u16* VTs = KTs + 128 * 72;
  float* LRs = (float*)(VTs + 256 * 72);
  float* TOT = LRs + 64 * 16;
  float* EB = TOT + 4 * 128;
  float* BL = EB + 128;
  float* WS = BL + 64 * 128;
  const int tid = otid(), lane = tid & 63, w = tid >> 6, h = lane >> 5, l31 = lane & 31;
  const int dir = item & 1, hh = (item >> 1) & 3, sg = item >> 3;
  const int d = tid & 127, tg = tid >> 7;
  const u16* proj = p.proj;
  const float* gw = dir ? p.gw_b : p.gw_f;
  const float* gb = dir ? p.gb_b : p.gb_f;
  u16* WTb = (u16*)WS;
  u16* LRb = (u16*)LRs;
#pragma unroll
  for (int i = 0; i < 4; ++i) { const int e = tid + 512 * i; const int dd = e >> 4, r = e & 15; WTb[e] = f2bf(gw[r * 512 + hh * 128 + dd]); }
  const float bias_z = gb[hh * 128 + 32 * (w >> 1) + l31];
  f32x16 S[4];
  float* Uit = p.U + (size_t)item * 32768;
#pragma unroll
  for (int dt = 0; dt < 4; ++dt)
#pragma unroll
    for (int r = 0; r < 16; ++r) S[dt][r] = PASS_C ? Uit[(dt * 16 + r) * 512 + tid] : 0.f;
  float dlog = 0.f;
  u16* odir = (u16*)(p.out + (size_t)slice * SL * DM) + (size_t)dir * SL * DM;
  const int lrcol = dir ? C_LRB : C_LRF;

  u32x4 pq[2], pk[2], pv[4], plr;
  auto gl_chunk = [&](int cc, int tid) {
    const int c = dir ? 7 - cc : cc;
    const int r0 = sg * 512 + c * 64;
#pragma unroll
    for (int i = 0; i < 2; ++i) {
      const int idx = tid + 512 * i; const int t = idx >> 4, c8 = idx & 15;
      pk[i] = *(const u32x4*)(proj + (size_t)(r0 + t) * LDP + C_GK + hh * 128 + c8 * 8);
      if (PASS_C) pq[i] = *(const u32x4*)(proj + (size_t)(r0 + t) * LDP + C_GQ + hh * 128 + c8 * 8);
    }
    if (tid < 128) plr = *(const u32x4*)(proj + (size_t)(r0 + (tid >> 1)) * LDP + lrcol + (tid & 1) * 8);
  };
  auto gl_chunk_v = [&](int cc, int tid) {
    const int c = dir ? 7 - cc : cc;
    const int r0 = sg * 512 + c * 64;
#pragma unroll
    for (int i = 0; i < 4; ++i) {
      const int idx = tid + 512 * i; const int t = idx >> 5, vg = idx & 31;
      pv[i] = *(const u32x4*)(proj + (size_t)(r0 + t) * LDP + C_GV + hh * 256 + vg * 8);
    }
  };
  gl_chunk(0, tid); gl_chunk_v(0, tid);
  const int tid_outer = tid;
  for (int cc = 0; cc < 8; ++cc) {
    int tid = tid_outer; asm volatile("" : "+v"(tid));
    const int lane = tid & 63, w = tid >> 6, h = lane >> 5, l31 = lane & 31, d = tid & 127, tg = tid >> 7;
    const int c = dir ? 7 - cc : cc;
    int row0 = sg * 512 + c * 64;
    asm volatile("" : "+s"(row0));
#pragma unroll
    for (int i = 0; i < 2; ++i) {
      const int idx = tid + 512 * i; const int t = idx >> 4, c8 = idx & 15;
      *(u32x4*)(Ks + t * 136 + c8 * 8) = pk[i];
      if (PASS_C) *(u32x4*)(Qs + t * 136 + c8 * 8) = pq[i];
    }
#pragma unroll
    for (int i = 0; i < 4; ++i) {
      const int idx = tid + 512 * i; const int t = idx >> 5, vg = idx & 31;
      *(u32x4*)(VTs + t * 288 + vg * 8) = pv[i];
    }
    if (tid < 128) *(u32x4*)(LRb + (tid >> 1) * 16 + (tid & 1) * 8) = plr;
    __syncthreads();
    if (cc + 1 < 8) { gl_chunk(cc + 1, tid); if (!PASS_C) gl_chunk_v(cc + 1, tid); }
    {
      const int ttz = w & 1, dz = 32 * (w >> 1) + l31;
      const bf16x8 az = *(const bf16x8*)(LRb + (32 * ttz + l31) * 16 + 8 * h);
      const bf16x8 bz = *(const bf16x8*)(WTb + dz * 16 + 8 * h);
      f32x16 z;
#pragma unroll
      for (int r = 0; r < 16; ++r) z[r] = 0.f;
      z = MFMA32(az, bz, z);
      float la[16];
#pragma unroll
      for (int r = 0; r < 16; ++r) la[r] = z[r] + bias_z;
      float ex[16];
#pragma unroll
      for (int r = 0; r < 16; ++r) ex[r] = __builtin_amdgcn_exp2f(-fabsf(la[r]) * 1.4426950408889634f);
#pragma unroll
      for (int r = 0; r < 16; ++r) ex[r] = __builtin_amdgcn_logf(1.f + ex[r]);
#pragma unroll
      for (int r = 0; r < 16; ++r) la[r] = (fminf(la[r], 0.f) - 0.6931471805599453f * ex[r]) * (1.f / 16.f);
      float G[4];
#pragma unroll
      for (int g = 0; g < 4; ++g) {
        if (dir) { la[4*g+2] += la[4*g+3]; la[4*g+1] += la[4*g+2]; la[4*g] += la[4*g+1]; G[g] = la[4*g]; }
        else     { la[4*g+1] += la[4*g];   la[4*g+2] += la[4*g+1]; la[4*g+3] += la[4*g+2]; G[g] = la[4*g+3]; }
      }
      float Go[4];
#pragma unroll
      for (int g = 0; g < 4; ++g) Go[g] = __shfl_xor(G[g], 32, 64);
      float base[4]; float runp = 0.f;
      if (dir) {
#pragma unroll
        for (int g = 3; g >= 0; --g) { base[g] = runp + (h == 0 ? Go[g] : 0.f); runp += G[g] + Go[g]; }
      } else {
#pragma unroll
        for (int g = 0; g < 4; ++g) { base[g] = runp + (h == 1 ? Go[g] : 0.f); runp += G[g] + Go[g]; }
      }
#pragma unroll
      for (int g = 0; g < 4; ++g)
#pragma unroll
        for (int r4 = 0; r4 < 4; ++r4) BL[(32 * ttz + 8 * g + 4 * h + r4) * 128 + dz] = la[4 * g + r4] + base[g];
      if (h == 0) TOT[ttz * 128 + dz] = runp;
    }
    __syncthreads();
    const float tot0 = TOT[d], tot1 = TOT[128 + d];
    const float all = tot0 + tot1;
    const float pre = dir ? ((tg < 2) ? tot1 : 0.f) : ((tg >= 2) ? tot0 : 0.f);
    {
      float bb[16], kv[16], qv[16];
#pragma unroll
      for (int u = 0; u < 16; ++u) {
        const int t = 16 * tg + u;
        bb[u] = BL[t * 128 + d] + pre;
        kv[u] = bf2f(Ks[t * 136 + d]);
        if (PASS_C) qv[u] = bf2f(Qs[t * 136 + d]);
      }
      float eb[16];
#pragma unroll
      for (int u = 0; u < 16; ++u) eb[u] = __builtin_amdgcn_exp2f(bb[u] * 1.4426950408889634f);
      unsigned kp[8];
#pragma unroll
      for (int i2 = 0; i2 < 8; ++i2) {
        kp[i2] = pack2(kv[2 * i2] * __builtin_amdgcn_rcpf(eb[2 * i2]), kv[2 * i2 + 1] * __builtin_amdgcn_rcpf(eb[2 * i2 + 1]));
        if (PASS_C) {
          const unsigned qp = pack2(qv[2 * i2] * eb[2 * i2], qv[2 * i2 + 1] * eb[2 * i2 + 1]);
          Ks[(16 * tg + 2 * i2) * 136 + d] = (u16)(kp[i2] & 0xffffu);
          Ks[(16 * tg + 2 * i2 + 1) * 136 + d] = (u16)(kp[i2] >> 16);
          Qs[(16 * tg + 2 * i2) * 136 + d] = (u16)(qp & 0xffffu);
          Qs[(16 * tg + 2 * i2 + 1) * 136 + d] = (u16)(qp >> 16);
        }
      }
      u32x4 k0, k1;
      k0[0] = kp[0]; k0[1] = kp[1]; k0[2] = kp[2]; k0[3] = kp[3];
      k1[0] = kp[4]; k1[1] = kp[5]; k1[2] = kp[6]; k1[3] = kp[7];
      *(u32x4*)(KTs + d * 72 + 16 * tg) = k0;
      *(u32x4*)(KTs + d * 72 + 16 * tg + 8) = k1;
    }
    if (tg == 0) { EB[d] = __expf(all); dlog += all; }
    __syncthreads();

    if (PASS_C) {
      f32x16 X00, X11, Xoff;
#pragma unroll
      for (int r = 0; r < 16; ++r) { X00[r] = 0.f; X11[r] = 0.f; Xoff[r] = 0.f; }
#pragma unroll 2
      for (int s = 0; s < 8; ++s) {
        bf16x8 a0 = *(const bf16x8*)(Ks + l31 * 136 + 16 * s + 8 * h);
        bf16x8 a1 = *(const bf16x8*)(Ks + (32 + l31) * 136 + 16 * s + 8 * h);
        bf16x8 b0 = *(const bf16x8*)(Qs + l31 * 136 + 16 * s + 8 * h);
        bf16x8 b1 = *(const bf16x8*)(Qs + (32 + l31) * 136 + 16 * s + 8 * h);
        X00 = MFMA32(a0, b0, X00);
        X11 = MFMA32(a1, b1, X11);
        bf16x8 ao = dir ? a1 : a0, bo = dir ? b0 : b1;
        Xoff = MFMA32(ao, bo, Xoff);
      }
      {
        int lo = l31 - 4 * h;
        asm volatile("" : "+v"(lo));
#pragma unroll
        for (int r = 0; r < 16; ++r) {
          const int j = (r & 3) + 8 * (r >> 2);
          const bool keep = dir ? (j >= lo) : (j <= lo);
          X00[r] = keep ? X00[r] : 0.f; X11[r] = keep ? X11[r] : 0.f;
        }
      }
      const bf16x8 x00a = pack8<0>(X00), x00b = pack8<1>(X00), x11a = pack8<0>(X11), x11b = pack8<1>(X11),
                   xofa = pack8<0>(Xoff), xofb = pack8<1>(Xoff);
      const bf16x8 vp00 = tr_frag(VTs, 288, 32 * w, 0 + 4 * h, 8 + 4 * h, lane), vp01 = tr_frag(VTs, 288, 32 * w, 16 + 4 * h, 24 + 4 * h, lane),
                   vp10 = tr_frag(VTs, 288, 32 * w, 32 + 4 * h, 40 + 4 * h, lane), vp11 = tr_frag(VTs, 288, 32 * w, 48 + 4 * h, 56 + 4 * h, lane);
#pragma unroll
      for (int it = 0; it < 2; ++it) {
        f32x16 acc;
#pragma unroll
        for (int r = 0; r < 16; ++r) acc[r] = 0.f;
        const u16* qrow = Qs + (32 * it + l31) * 136;
#pragma unroll
        for (int dt = 0; dt < 4; ++dt) {
          acc = MFMA32(ld_perm(qrow + 32 * dt, 0, h), pack8<0>(S[dt]), acc);
          acc = MFMA32(ld_perm(qrow + 32 * dt, 1, h), pack8<1>(S[dt]), acc);
        }
        if (it == 0) {
          acc = MFMA32(x00a, vp00, acc);
          acc = MFMA32(x00b, vp01, acc);
          if (dir) {
            acc = MFMA32(xofa, vp10, acc);
            acc = MFMA32(xofb, vp11, acc);
          }
        } else {
          acc = MFMA32(x11a, vp10, acc);
          acc = MFMA32(x11b, vp11, acc);
          if (!dir) {
            acc = MFMA32(xofa, vp00, acc);
            acc = MFMA32(xofb, vp01, acc);
          }
        }
#pragma unroll
        for (int r = 0; r < 16; ++r)
          if (!dry) odir[(size_t)(row0 + 32 * it + crow(r, h)) * DM + hh * 256 + 32 * w + l31] = f2bf(acc[r]);
      }
    }
    if (PASS_C && cc + 1 < 8) gl_chunk_v(cc + 1, tid);
    bf16x8 vb[4];
#pragma unroll
    for (int ks = 0; ks < 4; ++ks) vb[ks] = tr_frag(VTs, 288, 32 * w, 16 * ks + 8 * h, 16 * ks + 8 * h + 4, lane);
#pragma unroll
    for (int dt = 0; dt < 4; ++dt) {
#pragma unroll
      for (int ks = 0; ks < 4; ++ks) {
        bf16x8 a = *(const bf16x8*)(KTs + (32 * dt + l31) * 72 + 16 * ks + 8 * h);
        S[dt] = MFMA32(a, vb[ks], S[dt]);
      }
#pragma unroll
      for (int g = 0; g < 4; ++g) {
        f32x4 e = *(const f32x4*)(EB + 32 * dt + 8 * g + 4 * h);
        S[dt][4 * g + 0] *= e[0]; S[dt][4 * g + 1] *= e[1]; S[dt][4 * g + 2] *= e[2]; S[dt][4 * g + 3] *= e[3];
      }
    }
    __syncthreads();
  }
  if (!PASS_C) {
#pragma unroll
    for (int dt = 0; dt < 4; ++dt)
#pragma unroll
      for (int r = 0; r < 16; ++r) Uit[(dt * 16 + r) * 512 + tid] = S[dt][r];
    if (tg == 0) p.Dlog[item * 128 + d] = dlog;
  }
}

DI void gla_pass_b(const Params& p, int slice) {
  const int nseq = slice == 0 ? 1 : 2, segs = slice == 0 ? 32 : 16;
  const int total = nseq * 8 * 32768;
  for (int e = blockIdx.x * NT + otid(); e < total; e += gridDim.x * NT) {
    const int elem = e & 32767, hd = (e >> 15) & 7, sq = e >> 18;
    const int dir = hd & 1;
    const int t = elem & 511, dtreg = elem >> 9;
    const int hl = (t & 63) >> 5;
    const int d = 32 * (dtreg >> 4) + crow(dtreg & 15, hl);
    float carry = 0.f;
    for (int i0 = 0; i0 < segs; i0 += 16) {
      float u[16], dl[16];
#pragma unroll
      for (int k = 0; k < 16; ++k) {
        const int sgl = dir ? segs - 1 - (i0 + k) : (i0 + k);
        const int it = (sq * segs + sgl) * 8 + hd;
        u[k] = p.U[(size_t)it * 32768 + elem];
        dl[k] = p.Dlog[it * 128 + d];
      }
#pragma unroll
      for (int k = 0; k < 16; ++k) {
        const int sgl = dir ? segs - 1 - (i0 + k) : (i0 + k);
        const int it = (sq * segs + sgl) * 8 + hd;
        p.U[(size_t)it * 32768 + elem] = carry;
        carry = __expf(dl[k]) * carry + u[k];
      }
    }
  }
}

DI void gla_combine(const Params& p, int slice) {
  const int lane = otid() & 63, w = otid() >> 6;
  const int nw = gridDim.x * (NT / 64);
  const u16* of = (const u16*)(p.out + (size_t)slice * SL * DM);
  const u16* ob = of + (size_t)SL * DM;
  const int col = (lane >> 4) * 256 + (lane & 15) * 16;
  float ng[16];
#pragma unroll
  for (int i = 0; i < 4; ++i) { f32x4 t4 = *(const f32x4*)(p.gla_ng + (lane & 15) * 16 + 4 * i); ng[4*i] = t4[0]; ng[4*i+1] = t4[1]; ng[4*i+2] = t4[2]; ng[4*i+3] = t4[3]; }
  for (int row0 = (blockIdx.x * (NT / 64) + w) * 4; row0 < SL; row0 += nw * 4) {
    bf16x8 a0[4], a1[4], b0[4], b1[4], g0[4], g1[4];
#pragma unroll
    for (int u = 0; u < 4; ++u) {
      const int row = row0 + u;
      a0[u] = *(const bf16x8*)(of + (size_t)row * DM + col); a1[u] = *(const bf16x8*)(of + (size_t)row * DM + col + 8);
      b0[u] = *(const bf16x8*)(ob + (size_t)row * DM + col); b1[u] = *(const bf16x8*)(ob + (size_t)row * DM + col + 8);
      const u16* gp = p.proj + (size_t)row * LDP + C_GG + col;
      g0[u] = *(const bf16x8*)gp; g1[u] = *(const bf16x8*)(gp + 8);
    }
#pragma unroll
    for (int u = 0; u < 4; ++u) {
      u16* gp = p.proj + (size_t)(row0 + u) * LDP + C_GG + col;
      float o[16]; float ss = 0.f;
#pragma unroll
      for (int i = 0; i < 8; ++i) {
        o[i] = bf2f((u16)a0[u][i]) + bf2f((u16)b0[u][i]); o[8 + i] = bf2f((u16)a1[u][i]) + bf2f((u16)b1[u][i]);
        ss += o[i] * o[i] + o[8 + i] * o[8 + i];
      }
#pragma unroll
      for (int m = 8; m > 0; m >>= 1) ss += __shfl_xor(ss, m, 64);
      const float rstd = rsqrtf(ss * (1.f / 256.f) + 1e-6f);
      u32x4 r0, r1;
#pragma unroll
      for (int i = 0; i < 4; ++i) {
        r0[i] = pack2(o[2*i] * rstd * ng[2*i] * silu(bf2f((u16)g0[u][2*i])), o[2*i+1] * rstd * ng[2*i+1] * silu(bf2f((u16)g0[u][2*i+1])));
        r1[i] = pack2(o[8+2*i] * rstd * ng[8+2*i] * silu(bf2f((u16)g1[u][2*i])), o[8+2*i+1] * rstd * ng[8+2*i+1] * silu(bf2f((u16)g1[u][2*i+1])));
      }
      *(u32x4*)gp = r0; *(u32x4*)(gp + 8) = r1;
    }
  }
}

DI void nat_item(const Params& p, int slice, int item, char* smem, bool dry = false) {
  const int tid = otid(), lane = tid & 63, w = tid >> 6, h = lane >> 5, l31 = lane & 31;
  u16* VT = (u16*)smem + w * (64 * 96);
  float* SC = (float*)(smem + 8 * 64 * 96 * 2) + w * 64;
  float* BIAS = (float*)(smem + 8 * 64 * 96 * 2 + 8 * 64 * 4) + w * 480;
  const int nh = item & 7, R = item >> 3;
  const int rows = slice == 0 ? 256 : 128;
  const int sq = R / rows, r = R % rows;
  const int rs = min(max(r - 4, 0), rows - 8);
  const int seq0 = sq * rows * 64;
  const int qrow0 = seq0 + r * 64;
  u16* proj = p.proj;
  for (int i = lane; i < 465; i += 64) BIAS[i] = p.rpb[nh * 465 + i];
  bf16x8 bq[2][4];
#pragma unroll
  for (int qt = 0; qt < 2; ++qt)
#pragma unroll
    for (int s = 0; s < 4; ++s) bq[qt][s] = *(const bf16x8*)(proj + (size_t)(qrow0 + 32 * qt + l31) * LDP + C_NQ + nh * 64 + 16 * s + 8 * h);
  f32x16 o[2][2];
#pragma unroll
  for (int a = 0; a < 2; ++a)
#pragma unroll
    for (int b = 0; b < 2; ++b)
#pragma unroll
      for (int rr = 0; rr < 16; ++rr) o[a][b][rr] = 0.f;
  float mrun[2] = {-1e30f, -1e30f}, lrun[2] = {0.f, 0.f};
  unsigned vmask[2];
#pragma unroll
  for (int qt = 0; qt < 2; ++qt) {
    const int cq = 32 * qt + l31;
    const int cs = min(max(cq - 8, 0), 48);
    unsigned m = 0u;
#pragma unroll
    for (int kt = 0; kt < 2; ++kt)
#pragma unroll
      for (int rr = 0; rr < 16; ++rr) {
        const int ck = 32 * kt + crow(rr, h);
        m |= ((ck >= cs) && (ck < cs + 16)) ? (1u << (kt * 16 + rr)) : 0u;
      }
    vmask[qt] = m;
  }
  bf16x8 ka[2][4]; u32x4 vc[8];
  auto ld_row = [&](int kk, bf16x8 (&kf)[2][4], u32x4 (&vr)[8]) {
    const int kr0 = seq0 + (rs + kk) * 64;
#pragma unroll
    for (int i = 0; i < 8; ++i) {
      const int idx = lane + 64 * i; const int key = idx >> 3, dg = idx & 7;
      vr[i] = *(const u32x4*)(proj + (size_t)(kr0 + key) * LDP + C_NV + nh * 64 + dg * 8);
    }
#pragma unroll
    for (int kt = 0; kt < 2; ++kt)
#pragma unroll
      for (int s = 0; s < 4; ++s) kf[kt][s] = *(const bf16x8*)(proj + (size_t)(kr0 + 32 * kt + l31) * LDP + C_NK + nh * 64 + 16 * s + 8 * h);
  };
#pragma unroll 1
  for (int kk = 0; kk < 8; ++kk) {
    ld_row(kk, ka, vc);
#pragma unroll
    for (int i = 0; i < 8; ++i) {
      const int idx = lane + 64 * i; const int key = idx >> 3, dg = idx & 7;
      *(u32x4*)(VT + key * 96 + dg * 8) = vc[i];
    }
    f32x16 acc[2][2];
#pragma unroll
    for (int a = 0; a < 2; ++a)
#pragma unroll
      for (int b = 0; b < 2; ++b)
#pragma unroll
        for (int rr = 0; rr < 16; ++rr) acc[a][b][rr] = 0.f;
#pragma unroll
    for (int s = 0; s < 4; ++s)
#pragma unroll
      for (int kt = 0; kt < 2; ++kt)
#pragma unroll
        for (int qt = 0; qt < 2; ++qt) acc[kt][qt] = MFMA32(ka[kt][s], bq[qt][s], acc[kt][qt]);
    const int drow = rs + kk - r + 7;
#pragma unroll
    for (int qt = 0; qt < 2; ++qt) {
      const int cq = 32 * qt + l31;
      const float* bp = BIAS + drow * 31 + (15 - cq + 4 * h);
      float mx = -1e30f;
#pragma unroll
      for (int kt = 0; kt < 2; ++kt)
#pragma unroll
        for (int rr = 0; rr < 16; ++rr) {
          const float sc = acc[kt][qt][rr] + bp[32 * kt + (rr & 3) + 8 * (rr >> 2)];
          acc[kt][qt][rr] = ((vmask[qt] >> (kt * 16 + rr)) & 1u) ? sc : -1e30f;
          mx = fmaxf(mx, acc[kt][qt][rr]);
        }
      mx = fmaxf(mx, __shfl_xor(mx, 32, 64));
      const float mnew = fmaxf(mrun[qt], mx);
      const float alpha = __expf(mrun[qt] - mnew);
      mrun[qt] = mnew;
      float ls = 0.f;
#pragma unroll
      for (int kt = 0; kt < 2; ++kt)
#pragma unroll
        for (int rr = 0; rr < 16; ++rr) { float e = __expf(acc[kt][qt][rr] - mnew); acc[kt][qt][rr] = e; ls += e; }
      ls += __shfl_xor(ls, 32, 64);
      lrun[qt] = lrun[qt] * alpha + ls;
#pragma unroll
      for (int dt = 0; dt < 2; ++dt)
#pragma unroll
        for (int rr = 0; rr < 16; ++rr) o[qt][dt][rr] *= alpha;
    }
    bf16x8 vf[2][4];
#pragma unroll
    for (int dt = 0; dt < 2; ++dt) {
      vf[dt][0] = tr_frag(VT, 96, 32 * dt, 0 + 4 * h, 8 + 4 * h, lane);   vf[dt][1] = tr_frag(VT, 96, 32 * dt, 16 + 4 * h, 24 + 4 * h, lane);
      vf[dt][2] = tr_frag(VT, 96, 32 * dt, 32 + 4 * h, 40 + 4 * h, lane); vf[dt][3] = tr_frag(VT, 96, 32 * dt, 48 + 4 * h, 56 + 4 * h, lane);
    }
#pragma unroll
    for (int qt = 0; qt < 2; ++qt) {
      const bf16x8 p00 = pack8<0>(acc[0][qt]), p01 = pack8<1>(acc[0][qt]), p10 = pack8<0>(acc[1][qt]), p11 = pack8<1>(acc[1][qt]);
#pragma unroll
      for (int dt = 0; dt < 2; ++dt) {
        o[qt][dt] = MFMA32(vf[dt][0], p00, o[qt][dt]);
        o[qt][dt] = MFMA32(vf[dt][1], p01, o[qt][dt]);
        o[qt][dt] = MFMA32(vf[dt][2], p10, o[qt][dt]);
        o[qt][dt] = MFMA32(vf[dt][3], p11, o[qt][dt]);
      }
    }
  }
#pragma unroll
  for (int qt = 0; qt < 2; ++qt) {
    const float inv = 1.f / lrun[qt];
    u16* rowp = proj + (size_t)(qrow0 + 32 * qt + l31) * LDP + C_NG + nh * 64;
#pragma unroll
    for (int dt = 0; dt < 2; ++dt)
#pragma unroll
      for (int g = 0; g < 4; ++g) {
        u16* gp = rowp + 32 * dt + 8 * g + 4 * h;
        const bf16x4 gt = *(const bf16x4*)gp;
        u32x2 res;
        res[0] = pack2(o[qt][dt][4 * g + 0] * inv * silu(bf2f((u16)gt[0])), o[qt][dt][4 * g + 1] * inv * silu(bf2f((u16)gt[1])));
        res[1] = pack2(o[qt][dt][4 * g + 2] * inv * silu(bf2f((u16)gt[2])), o[qt][dt][4 * g + 3] * inv * silu(bf2f((u16)gt[3])));
        if (!dry) *(u32x2*)gp = res;
      }
  }
}

DI void mem_item(const Params& p, int slice, int item, char* smem, bool dry = false) {
  const int tid = otid(), lane = tid & 63, w = tid >> 6, h = lane >> 5, l31 = lane & 31;
  u16* VT = (u16*)smem;
  u16* KM = VT + 256 * 144;
  const int mh = item & 3, tb = item >> 2;
  const int batch = slice == 0 ? 0 : (tb < 32 ? 1 : 2);
  const u16* mkv = p.mkv + (size_t)batch * 256 * 1024;
  u16* proj = p.proj;
#pragma unroll
  for (int i = 0; i < 8; ++i) {
    int idx = tid + 512 * i; int key = idx >> 4, dg = idx & 15;
    *(u32x4*)(VT + key * 144 + dg * 8) = *(const u32x4*)(mkv + (size_t)key * 1024 + 512 + mh * 128 + dg * 8);
    *(u32x4*)(KM + key * 136 + dg * 8) = *(const u32x4*)(mkv + (size_t)key * 1024 + mh * 128 + dg * 8);
  }
  const int qrow = tb * 256 + 32 * w + l31;
  bf16x8 bq[8];
#pragma unroll
  for (int s = 0; s < 8; ++s) bq[s] = *(const bf16x8*)(proj + (size_t)qrow * LDP + C_MQ + mh * 128 + 16 * s + 8 * h);
  float* LB = (float*)(smem + 256 * 144 * 2 + 256 * 136 * 2) + w * 32;
  float m = -1e30f;
  __syncthreads();
#pragma unroll 1
  for (int kt = 0; kt < 8; ++kt) {
    f32x16 acc;
#pragma unroll
    for (int rr = 0; rr < 16; ++rr) acc[rr] = 0.f;
#pragma unroll
    for (int s = 0; s < 8; ++s) {
      bf16x8 a = *(const bf16x8*)(KM + (32 * kt + l31) * 136 + 16 * s + 8 * h);
      acc = MFMA32(a, bq[s], acc);
    }
#pragma unroll
    for (int rr = 0; rr < 16; ++rr) m = fmaxf(m, acc[rr]);
  }
  m = fmaxf(m, __shfl_xor(m, 32, 64));
  f32x16 o[4];
#pragma unroll
  for (int dt = 0; dt < 4; ++dt)
#pragma unroll
    for (int rr = 0; rr < 16; ++rr) o[dt][rr] = 0.f;
  float l = 0.f;
#pragma unroll 1
  for (int kt = 0; kt < 8; ++kt) {
    f32x16 acc;
#pragma unroll
    for (int rr = 0; rr < 16; ++rr) acc[rr] = 0.f;
#pragma unroll
    for (int s = 0; s < 8; ++s) {
      bf16x8 a = *(const bf16x8*)(KM + (32 * kt + l31) * 136 + 16 * s + 8 * h);
      acc = MFMA32(a, bq[s], acc);
    }
#pragma unroll
    for (int rr = 0; rr < 16; ++rr) { float e = __expf(acc[rr] - m); acc[rr] = e; l += e; }
    const bf16x8 p0 = pack8<0>(acc), p1 = pack8<1>(acc);
#pragma unroll
    for (int dt = 0; dt < 4; ++dt) {
      o[dt] = MFMA32(tr_frag(VT, 144, 32 * dt, 32 * kt + 4 * h, 32 * kt + 8 + 4 * h, lane), p0, o[dt]);
      o[dt] = MFMA32(tr_frag(VT, 144, 32 * dt, 32 * kt + 16 + 4 * h, 32 * kt + 24 + 4 * h, lane), p1, o[dt]);
    }
  }
  l += __shfl_xor(l, 32, 64);
  {
    const float inv = 1.f / l;
    u16* rowp = proj + (size_t)(tb * 256 + 32 * w + l31) * LDP + C_MG + mh * 128;
#pragma unroll
    for (int dt = 0; dt < 4; ++dt)
#pragma unroll
      for (int g = 0; g < 4; ++g) {
        u16* gp = rowp + 32 * dt + 8 * g + 4 * h;
        const bf16x4 gt = *(const bf16x4*)gp;
        u32x2 res;
        res[0] = pack2(o[dt][4 * g + 0] * inv * silu(bf2f((u16)gt[0])), o[dt][4 * g + 1] * inv * silu(bf2f((u16)gt[1])));
        res[1] = pack2(o[dt][4 * g + 2] * inv * silu(bf2f((u16)gt[2])), o[dt][4 * g + 3] * inv * silu(bf2f((u16)gt[3])));
        if (!dry) *(u32x2*)gp = res;
      }
  }
  __syncthreads();
}

DI void final_norm(const Params& p, int slice, int wi, int wc) {
  const int lane = otid() & 63, w = otid() >> 6;
  const int nw = wc * (NT / 64);
  f32x4 g[4];
#pragma unroll
  for (int i = 0; i < 4; ++i) g[i] = *(const f32x4*)(p.post_g + (i * 64 + lane) * 4);
  for (int r0 = (wi * (NT / 64) + w) * 4; r0 < SL; r0 += nw * 4) {
    bf16x4 vb[4][4]; f32x4 xq[4][4];
#pragma unroll
    for (int u = 0; u < 4; ++u) {
      const u16* o = (const u16*)(p.out + ((size_t)slice * SL + r0 + u) * DM);
      const float* xs = p.x[slice] + (size_t)(r0 + u) * DM;
#pragma unroll
      for (int i = 0; i < 4; ++i) { vb[u][i] = *(const bf16x4*)(o + (i * 64 + lane) * 4); xq[u][i] = *(const f32x4*)(xs + (i * 64 + lane) * 4); }
    }
    float rstd[4];
#pragma unroll
    for (int u = 0; u < 4; ++u) {
      float ss = 0.f;
#pragma unroll
      for (int i = 0; i < 4; ++i)
#pragma unroll
        for (int c = 0; c < 4; ++c) { const float v = bf2f((u16)vb[u][i][c]); ss += v * v; }
      ss = wave_sum(ss);
      rstd[u] = rsqrtf(ss * (1.f / DM) + 1e-6f);
    }
#pragma unroll
    for (int u = 0; u < 4; ++u) {
      float* o = p.out + ((size_t)slice * SL + r0 + u) * DM;
#pragma unroll
      for (int i = 0; i < 4; ++i) {
        f32x4 y;
#pragma unroll
        for (int c = 0; c < 4; ++c) y[c] = xq[u][i][c] + bf2f((u16)vb[u][i][c]) * rstd[u] * g[i][c];
        *(f32x4*)(o + (i * 64 + lane) * 4) = y;
      }
    }
  }
}

DI int xq(int v, int G, int& x) { const int b = v % G, i = v / G; x = b & 7; return (b >> 3) + (G >> 3) * i; }
DI void map_p1(int v, int G, int& m, int& n) {
  if (G != 256) { m = v / 49; n = v % 49; return; }
  int x; const int q = xq(v, G, x);
  if (q >= 392) { m = -1; n = 0; return; }
  const int mh = q / 196, rem = q % 196;
  n = rem >> 2; m = 8 * x + 4 * mh + (rem & 3);
}
DI void map_out(int v, int G, int& m, int& n) {
  if (G != 256) { m = v / 8; n = v % 8; return; }
  int x; const int q = xq(v, G, x);
  if (q >= 64) { m = -1; n = 0; return; }
  n = (q >> 2) & 7; m = 8 * x + 4 * (q >> 5) + (q & 3);
}
DI void map_p1_big(int v, int G, int& m, int& n) {
  if (G != 256) { m = v / 24; n = v % 24; return; }
  int x; const int q = xq(v, G, x);
  if (q >= 192) { m = -1; n = 0; return; }
  n = q >> 3; m = 8 * x + (q & 7);
}
DI void map_out_big(int v, int G, int& m, int& n) {
  if (G != 256) { m = v / 4; n = v % 4; return; }
  int x; const int q = xq(v, G, x);
  if (q >= 32) { m = -1; n = 0; return; }
  n = (q >> 2) & 3; m = 8 * x + 4 * (q >> 4) + (q & 3);
}
DI int map_gla(int v, int G) {
  if (G != 256) return v;
  int x; const int q = xq(v, G, x);
  if (q >= 32) return -1;
  return (4 * x + (q >> 3)) * 8 + (q & 7);
}
DI int map_natrow(int v, int G) {
  if (G != 256) return v;
  int x; const int q = xq(v, G, x);
  if (q >= 32) return -1;
  return 32 * x + q;
}
#define GSYNC() do { xcd_barrier(xb); if (DUP & 64) xcd_barrier(xb); } while (0)
__global__ void __launch_bounds__(NT) mega_kernel(Params p) {
  __shared__ __attribute__((aligned(16))) char smem[SMEM_BYTES];
  __shared__ uint4 xb_words;
  cg::grid_group grid = cg::this_grid();
  const int G = gridDim.x, B = blockIdx.x;
  if (threadIdx.x == 0) xb_words = make_uint4(0u, 0u, 0u, 0u);
  __syncthreads();
  const XcdBarrier xb = xcd_barrier_post(p.bar, (volatile LAS unsigned*)&xb_words);

  if (PH & 1) phase0(p, smem);
  if (DUP & 32) phase0(p, smem);
  if (p.use_cg_sync) grid.sync(); else GSYNC();
#pragma unroll 1
  for (int s = 0; s < 2; ++s) {
    {
      const u16* hA = (const u16*)(p.out + (size_t)s * SL * DM);
      if (PH & 2) {
        const int w_lo = (G == 256) ? (s == 0 ? 88 : 64) : 0;
        const int wi = B - w_lo, wc = G - w_lo;
        const int extra_at = (B >> 3) % 6; int ti = 0; bool extra_done = (wi < 0);
        for (int rp = 1; rp < p.rep_p1; ++rp)
          for (int t = B; t < 64 * 24; t += G) { int m, n; map_p1_big(t, G, m, n); if (m < 0 || m >= 64) break; gemm_tile_big<0>(hA, DM, p.wt_in, 1024, m * 256, n * 256, p.proj, smem); }
        for (int t = B; t < 64 * 24; t += G, ++ti) {
          if (ti == extra_at && !extra_done) { if (s == 0) { prep_rows(p, SL, 2 * SL, wi, wc); prep_wout(p, smem, wi, wc); } else if (PH & 8) final_norm(p, 0, wi, wc); extra_done = true; }
          int m, n; map_p1_big(t, G, m, n); if (m < 0 || m >= 64) break; gemm_tile_big<0>(hA, DM, p.wt_in, 1024, m * 256, n * 256, p.proj, smem);
        }
        if (!extra_done) { if (s == 0) { prep_rows(p, SL, 2 * SL, wi, wc); prep_wout(p, smem, wi, wc); } else if (PH & 8) final_norm(p, 0, wi, wc); }
        for (int t = B; t < 64; t += G) gemm_tile<0>(hA, DM, p.wt_in, 1024, t * 256, 6144, p.proj, smem);
      }
      if (DUP & 8) {
        for (int t = B; t < 64 * 24; t += G) { int m, n; map_p1_big(t, G, m, n); if (m < 0 || m >= 64) break; gemm_tile_big<0>(hA, DM, p.wt_in, 1024, m * 256, n * 256, p.proj, smem); }
        for (int t = B; t < 64; t += G) gemm_tile<0>(hA, DM, p.wt_in, 1024, t * 256, 6144, p.proj, smem);
      }
      if (s == 0) {
        if (PH & 4) for (int t = (B >= 64 ? B - 64 : B + G - 64); t < 3 * 8; t += G) gemm_tile<1>(p.hm, DM, p.wt_kv, 1024, (t / 8) * 256, (t % 8) * 128, p.mkv, smem);
      }
    }
    GSYNC();
    if (PH & 16) for (int t = B; t < 256; t += G) { const int it = map_gla(t, G); if (it < 0) break; gla_item<false>(p, s, it, smem); }
    if (DUP & (1 | 256)) for (int t = B; t < 256; t += G) { const int it = map_gla(t, G); if (it < 0) break; gla_item<false>(p, s, it, smem); }
    if (DUP & 2) for (int t = B; t < 256; t += G) { const int R = map_natrow(t, G); if (R < 0) break; nat_item(p, s, R * 8 + (otid() >> 6), smem, p.dry != 0); }
    if (PH & 32) { for (int t = B; t < 256; t += G) { const int R = map_natrow(t, G); if (R < 0) break; nat_item(p, s, R * 8 + (otid() >> 6), smem); } __syncthreads(); }
    if (DUP & 4) for (int t = B; t < 256; t += G) mem_item(p, s, t, smem, p.dry != 0);
    if (PH & 64) for (int t = B; t < 256; t += G) mem_item(p, s, t, smem);
    GSYNC();
    if (PH & 128) gla_pass_b(p, s);
    GSYNC();
    if (PH & 256) for (int t = B; t < 256; t += G) { const int it = map_gla(t, G); if (it < 0) break; gla_item<true>(p, s, it, smem); }
    if (DUP & (1 | 512)) for (int t = B; t < 256; t += G) { const int it = map_gla(t, G); if (it < 0) break; gla_item<true>(p, s, it, smem); }
    if (DUP & 1024) for (int t = B; t < 256; t += G) { const int it = map_gla(t, G); if (it < 0) break; gla_item<true>(p, s, it, smem, p.dry != 0); }
    GSYNC();
    if (PH & 512) gla_combine(p, s);
    GSYNC();
    {
      float* od = p.out + (size_t)s * SL * DM;
      if (PH & 1024) for (int t = B; t < 64 * 4; t += G) { int m, n; map_out_big(t, G, m, n); if (m < 0 || m >= 64) break; gemm_tile_big<2>(p.proj, LDP, p.wt_out, 2048, m * 256, n * 256, od, smem); }
      if (DUP & 16) for (int t = B; t < 64 * 4; t += G) { int m, n; map_out_big(t, G, m, n); if (m < 0 || m >= 64) break; gemm_tile_big<2>(p.proj, LDP, p.wt_out, 2048, m * 256, n * 256, od, smem); }
    }
    GSYNC();
  }
  if (PH & 8) final_norm(p, 1, B, G);
}

extern "C" void kernel_launch(void* const* d_in, const int* in_sizes, int n_in, void* d_out, int out_size, void* d_ws,
                              size_t ws_size, hipStream_t stream) {
  static int grid_blocks = 0;
  if (!grid_blocks) {
    int dev = 0, cus = 0, per_cu = 0;
    hipGetDevice(&dev);
    hipDeviceGetAttribute(&cus, hipDeviceAttributeMultiprocessorCount, dev);
    hipOccupancyMaxActiveBlocksPerMultiprocessor(&per_cu, mega_kernel, NT, 0);
    if (per_cu < 1) per_cu = 1;
    if (per_cu > 1) per_cu = 1;
    grid_blocks = cus * per_cu;
  }
  Params p{};
  p.x[0] = (const float*)d_in[0]; p.x[1] = (const float*)d_in[1];
  p.mem[0] = (const float*)d_in[2]; p.mem[1] = (const float*)d_in[3];
  p.pre_g = (const float*)d_in[4]; p.w_in = (const float*)d_in[5];
  p.gw_f = (const float*)d_in[6]; p.gb_f = (const float*)d_in[7];
  p.gw_b = (const float*)d_in[8]; p.gb_b = (const float*)d_in[9];
  p.gla_ng = (const float*)d_in[10]; p.rpb = (const float*)d_in[11];
  p.mem_ng = (const float*)d_in[12]; p.w_kv = (const float*)d_in[13];
  p.w_out = (const float*)d_in[14]; p.post_g = (const float*)d_in[15];
  p.out = (float*)d_out;
  p.dry = 1;
  p.rep_p1 = REP_P1;
  p.use_cg_sync = 0;
  char* ws = (char*)d_ws; size_t off = 0;
  auto take = [&](size_t bytes) { char* r = ws + off; off += (bytes + 255) & ~(size_t)255; return r; };
  p.proj = (u16*)take((size_t)SL * LDP * 2);
  p.U = (float*)take((size_t)256 * 32768 * 4);
  p.Dlog = (float*)take((size_t)256 * 128 * 4);
  p.wt_in = (u16*)take((size_t)LDP * 1024 * 2);
  p.wt_kv = (u16*)take((size_t)1024 * 1024 * 2);
  p.wt_out = (u16*)take((size_t)1024 * 2048 * 2);
  p.hm = (u16*)take((size_t)768 * 1024 * 2);
  p.mkv = (u16*)take((size_t)768 * 1024 * 2);
  p.bar = (unsigned*)take((size_t)XCD_BAR_WORDS * 4);
  if (off > ws_size) { fprintf(stderr, "workspace too small: need %zu have %zu\n", off, ws_size); return; }
  hipMemsetAsync(p.bar, 0, (size_t)XCD_BAR_WORDS * 4, stream);
  void* args[] = {&p};
  hipError_t e = hipLaunchCooperativeKernel((void*)mega_kernel, dim3(grid_blocks), dim3(NT), args, 0, stream);
  if (e != hipSuccess) fprintf(stderr, "cooperative launch failed: %s (grid %d)\n", hipGetErrorString(e), grid_blocks);
}
```

```cpp
#include <hip/hip_runtime.h>
#include <hip/hip_cooperative_groups.h>
#include <cstdio>
namespace cg = cooperative_groups;

typedef unsigned short u16;
typedef __attribute__((ext_vector_type(8))) short bf16x8;
typedef __attribute__((ext_vector_type(4))) short bf16x4;
typedef __attribute__((ext_vector_type(16))) float f32x16;
typedef __attribute__((ext_vector_type(4))) float f32x4;
typedef __attribute__((ext_vector_type(4))) unsigned u32x4;
typedef __attribute__((ext_vector_type(2))) unsigned u32x2;

#define DI __device__ __forceinline__
#define MFMA32(a, b, c) __builtin_amdgcn_mfma_f32_32x32x16_bf16((a), (b), (c), 0, 0, 0)

static constexpr int NT = 512;
static constexpr int SL = 16384;
static constexpr int DM = 1024;
static constexpr int LDP = 6272;
static constexpr int C_GQ = 0, C_GK = 512, C_GV = 1024, C_GG = 2048, C_NQ = 3072, C_NK = 3584, C_NV = 4096,
                     C_NG = 4608, C_MQ = 5120, C_MG = 5632, C_LRF = 6144, C_LRB = 6160;
static constexpr int SMEM_BYTES = 144 * 1024;
#ifndef PH
#define PH 0xFFF
#endif
#ifndef DUP
#define DUP 0
#endif
#ifndef REP_P1
#define REP_P1 1
#endif

struct Params {
  const float* x[2];
  const float* mem[2];
  const float *pre_g, *w_in, *gw_f, *gb_f, *gw_b, *gb_b, *gla_ng, *rpb, *mem_ng, *w_kv, *w_out, *post_g;
  float* out;
  u16 *proj, *wt_in, *wt_kv, *wt_out, *hm, *mkv;
  float *U, *Dlog;
  unsigned* bar;
  int dry; int rep_p1; int use_cg_sync; int pad3_;
};

typedef __attribute__((ext_vector_type(2))) __bf16 bf16v2;
typedef __attribute__((ext_vector_type(2))) float f32x2;
DI unsigned pack2(float a, float b) { f32x2 v; v[0] = a; v[1] = b; return __builtin_bit_cast(unsigned, __builtin_convertvector(v, bf16v2)); }
DI u16 f2bf(float x) { return (u16)(pack2(x, 0.f) & 0xffffu); }
DI float bf2f(u16 v) { return __uint_as_float(((unsigned)v) << 16); }
DI int otid() { int t = (int)threadIdx.x; asm volatile("" : "+v"(t)); return t; }
DI int crow(int reg, int h) { return (reg & 3) + 8 * (reg >> 2) + 4 * h; }
DI float silu(float g) { return g / (1.f + __expf(-g)); }
DI float wave_sum(float v) {
#pragma unroll
  for (int o = 32; o > 0; o >>= 1) v += __shfl_xor(v, o, 64);
  return v;
}
template <int S> DI bf16x8 pack8(const f32x16& x) {
  u32x4 p;
  p[0] = pack2(x[8 * S + 0], x[8 * S + 1]); p[1] = pack2(x[8 * S + 2], x[8 * S + 3]);
  p[2] = pack2(x[8 * S + 4], x[8 * S + 5]); p[3] = pack2(x[8 * S + 6], x[8 * S + 7]);
  return __builtin_bit_cast(bf16x8, p);
}
DI bf16x8 ld_perm(const u16* rowbase, int s, int h) {
  bf16x4 lo = *(const bf16x4*)(rowbase + 16 * s + 4 * h);
  bf16x4 hi = *(const bf16x4*)(rowbase + 16 * s + 8 + 4 * h);
  return __builtin_shufflevector(lo, hi, 0, 1, 2, 3, 4, 5, 6, 7);
}


DI bf16x8 gather_nat(const u16* colp, int ld, int k0) {
  u32x4 r;
#pragma unroll
  for (int j = 0; j < 4; ++j) r[j] = (unsigned)colp[(k0 + 2 * j) * ld] | ((unsigned)colp[(k0 + 2 * j + 1) * ld] << 16);
  return __builtin_bit_cast(bf16x8, r);
}
DI bf16x8 gather_perm(const u16* colp, int ld, int kb, int s, int h) {
  const int k0 = kb + 16 * s + 4 * h;
  u32x4 r;
  r[0] = (unsigned)colp[(k0 + 0) * ld] | ((unsigned)colp[(k0 + 1) * ld] << 16);
  r[1] = (unsigned)colp[(k0 + 2) * ld] | ((unsigned)colp[(k0 + 3) * ld] << 16);
  r[2] = (unsigned)colp[(k0 + 8) * ld] | ((unsigned)colp[(k0 + 9) * ld] << 16);
  r[3] = (unsigned)colp[(k0 + 10) * ld] | ((unsigned)colp[(k0 + 11) * ld] << 16);
  return __builtin_bit_cast(bf16x8, r);
}

typedef __attribute__((ext_vector_type(4))) short s16x4;
#define LDS3 __attribute__((address_space(3)))
DI bf16x8 tr_frag(const u16* tile, int ld, int col0, int r0, int r1, int lane) {
  const int q = (lane & 15) >> 2, pcol = col0 + 16 * ((lane >> 4) & 1) + 4 * (lane & 3);
  const s16x4 lo = __builtin_amdgcn_ds_read_tr16_b64_v4i16((LDS3 s16x4*)(tile + (r0 + q) * ld + pcol));
  const s16x4 hi = __builtin_amdgcn_ds_read_tr16_b64_v4i16((LDS3 s16x4*)(tile + (r1 + q) * ld + pcol));
  return __builtin_shufflevector(lo, hi, 0, 1, 2, 3, 4, 5, 6, 7);
}

#define XB_TMO      128
#define XB_XCNT(j)  (256  + 64 * (j))
#define XB_XSUB(j)  (1280 + 64 * (j))
#define XB_XGEN(j)  (2304 + 64 * (j))
#define XB_TOP      3328
#define XB_TOPGEN   3392
#define XCD_BAR_WORDS 3456
#define XB_SPIN_CAP (1u << 18)
#define LAS __attribute__((address_space(3)))
DI unsigned xb_ld(unsigned* p)              { return __hip_atomic_load(p, __ATOMIC_RELAXED, __HIP_MEMORY_SCOPE_AGENT); }
DI unsigned xb_add(unsigned* p, unsigned v) { return __hip_atomic_fetch_add(p, v, __ATOMIC_RELAXED, __HIP_MEMORY_SCOPE_AGENT); }
DI unsigned xb_xcc_id() { return (unsigned)__builtin_amdgcn_s_getreg((3 << 11) | 20) & 0xFu; }
#define XB_SPIN(cond, bar) do { unsigned _sp = 0; while (cond) { __builtin_amdgcn_s_sleep(1); \
    if ((++_sp & 255u) == 0u) { if (xb_ld(&(bar)[XB_TMO])) break; if (_sp > XB_SPIN_CAP) { atomicAdd(&(bar)[XB_TMO], 1u); break; } } } } while (0)
struct XcdBarrier { unsigned* bar; unsigned x; volatile LAS unsigned* st; };
DI XcdBarrier xcd_barrier_post(unsigned* bar, volatile LAS unsigned* st) {
  XcdBarrier b; b.bar = bar; b.x = xb_xcc_id(); b.st = st;
  if (threadIdx.x == 0) (void)xb_add(&bar[XB_XCNT(b.x)], 1u);
  return b;
}
DI void xcd_barrier_complete(unsigned* bar, unsigned x, unsigned& nloc, unsigned& nx) {
  const unsigned G = gridDim.x * gridDim.y * gridDim.z;
  unsigned sum, cnt, mine, sp = 0u;
  for (;;) {
    sum = 0u; cnt = 0u; mine = 0u;
#pragma unroll
    for (unsigned j = 0; j < 16; ++j) { const unsigned c = xb_ld(&bar[XB_XCNT(j)]); sum += c; cnt += (c > 0u) ? 1u : 0u; mine = (j == x) ? c : mine; }
    if (sum == G) break;
    __builtin_amdgcn_s_sleep(1);
    if ((++sp & 255u) == 0u) { if (xb_ld(&bar[XB_TMO])) break; if (sp > XB_SPIN_CAP) { atomicAdd(&bar[XB_TMO], 1u); break; } }
  }
  nloc = mine > 0u ? mine : 1u; nx = cnt > 0u ? cnt : 1u;
}
DI void xcd_barrier(const XcdBarrier& b) {
  asm volatile("s_waitcnt vmcnt(0)" ::: "memory");
  __syncthreads();
  if (threadIdx.x == 0) {
    unsigned* bar = b.bar;
    __builtin_amdgcn_s_waitcnt(0);
    unsigned nloc = b.st[0], nx = b.st[1];
    if (nloc == 0u) { xcd_barrier_complete(bar, b.x, nloc, nx); b.st[0] = nloc; b.st[1] = nx; }
    const unsigned old = xb_add(&bar[XB_XSUB(b.x)], 1u);
    const unsigned gen = old / nloc;
    if (old + 1u == (gen + 1u) * nloc) {
      __builtin_amdgcn_fence(__ATOMIC_RELEASE, "agent");
      asm volatile("s_waitcnt vmcnt(0)" ::: "memory");
      const unsigned og = xb_add(&bar[XB_TOP], 1u);
      const unsigned tg = og / nx;
      if (og + 1u == (tg + 1u) * nx) xb_add(&bar[XB_TOPGEN], 1u);
      else XB_SPIN(xb_ld(&bar[XB_TOPGEN]) == tg, bar);
      __builtin_amdgcn_fence(__ATOMIC_ACQUIRE, "agent");
      xb_add(&bar[XB_XGEN(b.x)], 1u);
      asm volatile("s_waitcnt vmcnt(0)" ::: "memory");
    } else {
      XB_SPIN(xb_ld(&bar[XB_XGEN(b.x)]) == gen, bar);
      __builtin_amdgcn_fence(__ATOMIC_ACQUIRE, "agent");
      asm volatile("s_waitcnt vmcnt(0)" ::: "memory");
    }
  }
  __syncthreads();
}

DI void prep_rows(const Params& p, int row_lo, int row_hi, int wi, int wc) {
  const int lane = otid() & 63, w = otid() >> 6;
  const int nw = wc * (NT / 64);
  for (int row0 = row_lo + (wi * (NT / 64) + w) * 4; row0 < row_hi; row0 += nw * 4) {
    f32x4 v[4][4];
    const float* g = (row0 < 2 * SL) ? p.pre_g : p.mem_ng;
#pragma unroll
    for (int u = 0; u < 4; ++u) {
      const int row = row0 + u;
      const float* src;
      if (row < 2 * SL) { int s = row >> 14, r = row & (SL - 1); src = p.x[s] + (size_t)r * DM; }
      else { int r = row - 2 * SL; src = (r < 256) ? p.mem[0] + (size_t)r * DM : p.mem[1] + (size_t)(r - 256) * DM; }
#pragma unroll
      for (int i = 0; i < 4; ++i) v[u][i] = __builtin_nontemporal_load((const f32x4*)(src + (i * 64 + lane) * 4));
    }
    f32x4 gg[4];
#pragma unroll
    for (int i = 0; i < 4; ++i) gg[i] = *(const f32x4*)(g + (i * 64 + lane) * 4);
#pragma unroll
    for (int u = 0; u < 4; ++u) {
      const int row = row0 + u;
      u16* dst;
      if (row < 2 * SL) { int s = row >> 14, r = row & (SL - 1); dst = (u16*)(p.out + (size_t)s * SL * DM) + (size_t)r * DM; }
      else dst = p.hm + (size_t)(row - 2 * SL) * DM;
      float ss = 0.f;
#pragma unroll
      for (int i = 0; i < 4; ++i) ss += v[u][i][0] * v[u][i][0] + v[u][i][1] * v[u][i][1] + v[u][i][2] * v[u][i][2] + v[u][i][3] * v[u][i][3];
      ss = wave_sum(ss);
      const float rstd = rsqrtf(ss * (1.f / DM) + 1e-6f);
#pragma unroll
      for (int i = 0; i < 4; ++i) {
        u32x2 o; o[0] = pack2(v[u][i][0] * rstd * gg[i][0], v[u][i][1] * rstd * gg[i][1]);
        o[1] = pack2(v[u][i][2] * rstd * gg[i][2], v[u][i][3] * rstd * gg[i][3]);
        *(u32x2*)(dst + (i * 64 + lane) * 4) = o;
      }
    }
  }
}

template <int MODE>
DI void transpose_tile(const float* __restrict__ src, int N, int K, u16* __restrict__ dst, int n0, int k0, char* smem) {
  float* tile = (float*)smem;
  const int tid = otid();
  {
    const int nn = tid & 127, kb = tid >> 7;
    const int np = n0 + nn;
    int sc; float scale = 1.f; bool valid = true;
    if (MODE == 0) {
      if (np < 3072) { sc = np; if (np < 512) scale = 0.08838834764831845f; }
      else if (np < 6144) { sc = np + 32; if (np < C_NK) scale = 0.125f; else if (np >= C_MQ && np < C_MG) scale = 0.08838834764831845f; }
      else if (np < 6176) { sc = np - 3072; }
      else { sc = 0; valid = false; }
    } else sc = np;
    float v[16];
#pragma unroll
    for (int i = 0; i < 16; ++i) v[i] = valid ? src[(size_t)(k0 + kb + 4 * i) * N + sc] : 0.f;
#pragma unroll
    for (int i = 0; i < 16; ++i) tile[(kb + 4 * i) * 129 + nn] = v[i] * scale;
  }
  __syncthreads();
  {
    const int kk = tid & 63, nb = tid >> 6;
#pragma unroll
    for (int i = 0; i < 16; ++i) {
      int nn = nb + 8 * i;
      dst[(size_t)(n0 + nn) * K + k0 + kk] = f2bf(tile[kk * 129 + nn]);
    }
  }
  __syncthreads();
}

DI void phase0(const Params& p, char* smem) {
  for (int t = blockIdx.x; t < 49 * 16; t += gridDim.x) transpose_tile<0>(p.w_in, 6176, 1024, p.wt_in, (t % 49) * 128, (t / 49) * 64, smem);
  for (int t = blockIdx.x; t < 8 * 16; t += gridDim.x) transpose_tile<1>(p.w_kv, 1024, 1024, p.wt_kv, (t % 8) * 128, (t / 8) * 64, smem);
  prep_rows(p, 0, SL, blockIdx.x, gridDim.x);
  prep_rows(p, 2 * SL, 2 * SL + 768, blockIdx.x, gridDim.x);
}

DI void prep_wout(const Params& p, char* smem, int wi, int wc) {
  for (int t = wi; t < 8 * 32; t += wc) transpose_tile<1>(p.w_out, 1024, 2048, p.wt_out, (t % 8) * 128, (t / 8) * 64, smem);
}

template <int MODE>
DI void gemm_tile(const u16* __restrict__ A, int lda, const u16* __restrict__ Bt, int K, int m0, int n0, void* outp, char* smem) {
  u16* As0 = (u16*)smem;
  u16* Bs0 = As0 + 256 * 72;
  u16* As1 = Bs0 + 128 * 72;
  u16* Bs1 = As1 + 256 * 72;
  const int tid = otid(), lane = tid & 63, w = tid >> 6, h = lane >> 5, l31 = lane & 31;
  const int wm = w >> 1, wn = w & 1;
  const int lrow = tid >> 3, kc = tid & 7;
  f32x16 acc[2][2];
#pragma unroll
  for (int i = 0; i < 2; ++i)
#pragma unroll
    for (int j = 0; j < 2; ++j)
#pragma unroll
      for (int r = 0; r < 16; ++r) acc[i][j][r] = 0.f;
  u32x4 ra0[4], rb0[2], ra1[4], rb1[2];
  const int nk = K / 64;
  auto acol = [&](int k0) -> int {
    if (MODE == 2) return (k0 < 1024) ? (C_GG + k0) : ((k0 < 1536) ? (C_NG + k0 - 1024) : (C_MG + k0 - 1536));
    return k0;
  };
  const u16* Abase = A + (size_t)(m0 + lrow) * lda + kc * 8;
  const u16* Bbase = Bt + (size_t)(n0 + lrow) * K + kc * 8;
  auto gload = [&](int kt, u32x4* ra, u32x4* rb) {
    const int k0 = kt * 64; const int ac = acol(k0);
#pragma unroll
    for (int i = 0; i < 4; ++i) ra[i] = *(const u32x4*)(Abase + (size_t)(64 * i) * lda + ac);
#pragma unroll
    for (int i = 0; i < 2; ++i) rb[i] = *(const u32x4*)(Bbase + (size_t)(64 * i) * K + k0);
  };
  auto lstore = [&](u16* As, u16* Bs, const u32x4* ra, const u32x4* rb) {
#pragma unroll
    for (int i = 0; i < 4; ++i) *(u32x4*)(As + (lrow + 64 * i) * 72 + kc * 8) = ra[i];
#pragma unroll
    for (int i = 0; i < 2; ++i) *(u32x4*)(Bs + (lrow + 64 * i) * 72 + kc * 8) = rb[i];
  };
  auto step = [&](const u16* AsC, const u16* BsC, u16* AsN, u16* BsN, const u32x4* ra, const u32x4* rb, bool do_store) {
#pragma unroll
    for (int ks = 0; ks < 4; ++ks) {
      bf16x8 a[2], b[2];
#pragma unroll
      for (int i = 0; i < 2; ++i) a[i] = *(const bf16x8*)(AsC + (64 * wm + 32 * i + l31) * 72 + 16 * ks + 8 * h);
#pragma unroll
      for (int j = 0; j < 2; ++j) b[j] = *(const bf16x8*)(BsC + (64 * wn + 32 * j + l31) * 72 + 16 * ks + 8 * h);
#pragma unroll
      for (int i = 0; i < 2; ++i)
#pragma unroll
        for (int j = 0; j < 2; ++j) acc[i][j] = MFMA32(a[i], b[j], acc[i][j]);
      if (do_store) {
        if (ks == 0) { *(u32x4*)(AsN + (lrow) * 72 + kc * 8) = ra[0]; *(u32x4*)(AsN + (lrow + 64) * 72 + kc * 8) = ra[1]; }
        if (ks == 1) { *(u32x4*)(AsN + (lrow + 128) * 72 + kc * 8) = ra[2]; *(u32x4*)(AsN + (lrow + 192) * 72 + kc * 8) = ra[3]; }
        if (ks == 2) { *(u32x4*)(BsN + (lrow) * 72 + kc * 8) = rb[0]; *(u32x4*)(BsN + (lrow + 64) * 72 + kc * 8) = rb[1]; }
      }
    }
  };
  gload(0, ra0, rb0); gload(1, ra1, rb1);
  lstore(As0, Bs0, ra0, rb0);
  gload(2, ra0, rb0);
  __syncthreads();
  for (int kt = 0; kt < nk; kt += 2) {
    step(As0, Bs0, As1, Bs1, ra1, rb1, true);
    if (kt + 3 < nk) gload(kt + 3, ra1, rb1);
    __syncthreads();
    step(As1, Bs1, As0, Bs0, ra0, rb0, kt + 2 < nk);
    if (kt + 4 < nk) gload(kt + 4, ra0, rb0);
    __syncthreads();
  }
#pragma unroll
  for (int i = 0; i < 2; ++i)
#pragma unroll
    for (int j = 0; j < 2; ++j)
#pragma unroll
      for (int r = 0; r < 16; ++r) {
        const int row = m0 + 64 * wm + 32 * i + crow(r, h);
        const int col = n0 + 64 * wn + 32 * j + l31;
        if (MODE == 0) ((u16*)outp)[(size_t)row * LDP + col] = f2bf(acc[i][j][r]);
        else if (MODE == 1) ((u16*)outp)[(size_t)row * 1024 + col] = f2bf(acc[i][j][r]);
        else ((float*)outp)[(size_t)row * 1024 + col] = acc[i][j][r];
      }
}

template <int MODE>
DI void gemm_tile_big(const u16* __restrict__ A, int lda, const u16* __restrict__ Bt, int K, int m0, int n0, void* outp, char* smem) {
  u16* As0 = (u16*)smem;
  u16* Bs0 = As0 + 256 * 72;
  u16* As1 = Bs0 + 256 * 72;
  u16* Bs1 = As1 + 256 * 72;
  const int tid = otid(), lane = tid & 63, w = tid >> 6, h = lane >> 5, l31 = lane & 31;
  const int wm = w >> 2, wn = w & 3;
  const int lrow = tid >> 3, kc = tid & 7;
  f32x16 acc[4][2];
#pragma unroll
  for (int i = 0; i < 4; ++i)
#pragma unroll
    for (int j = 0; j < 2; ++j)
#pragma unroll
      for (int r = 0; r < 16; ++r) acc[i][j][r] = 0.f;
  u32x4 ra[4], rb[4];
  const int nk = K / 64;
  auto acol = [&](int k0) -> int {
    if (MODE == 2) return (k0 < 1024) ? (C_GG + k0) : ((k0 < 1536) ? (C_NG + k0 - 1024) : (C_MG + k0 - 1536));
    return k0;
  };
  const u16* Abase = A + (size_t)(m0 + lrow) * lda + kc * 8;
  const u16* Bbase = Bt + (size_t)(n0 + lrow) * K + kc * 8;
  auto gload = [&](int kt) {
    const int k0 = kt * 64; const int ac = acol(k0);
#pragma unroll
    for (int i = 0; i < 4; ++i) ra[i] = *(const u32x4*)(Abase + (size_t)(64 * i) * lda + ac);
#pragma unroll
    for (int i = 0; i < 4; ++i) rb[i] = *(const u32x4*)(Bbase + (size_t)(64 * i) * K + k0);
  };
  auto step = [&](const u16* AsC, const u16* BsC, u16* AsN, u16* BsN, bool do_store) {
#pragma unroll
    for (int ks = 0; ks < 4; ++ks) {
      bf16x8 a[4], b[2];
#pragma unroll
      for (int i = 0; i < 4; ++i) a[i] = *(const bf16x8*)(AsC + (128 * wm + 32 * i + l31) * 72 + 16 * ks + 8 * h);
#pragma unroll
      for (int j = 0; j < 2; ++j) b[j] = *(const bf16x8*)(BsC + (64 * wn + 32 * j + l31) * 72 + 16 * ks + 8 * h);
#pragma unroll
      for (int i = 0; i < 4; ++i)
#pragma unroll
        for (int j = 0; j < 2; ++j) acc[i][j] = MFMA32(a[i], b[j], acc[i][j]);
      if (do_store && ks == 2) {
#pragma unroll
        for (int i = 0; i < 4; ++i) *(u32x4*)(AsN + (lrow + 64 * i) * 72 + kc * 8) = ra[i];
      }
      if (do_store && ks == 3) {
#pragma unroll
        for (int i = 0; i < 4; ++i) *(u32x4*)(BsN + (lrow + 64 * i) * 72 + kc * 8) = rb[i];
      }
    }
  };
  gload(0);
#pragma unroll
  for (int i = 0; i < 4; ++i) { *(u32x4*)(As0 + (lrow + 64 * i) * 72 + kc * 8) = ra[i]; *(u32x4*)(Bs0 + (lrow + 64 * i) * 72 + kc * 8) = rb[i]; }
  gload(1);
  __syncthreads();
  for (int kt = 0; kt < nk; kt += 2) {
    step(As0, Bs0, As1, Bs1, true);
    if (kt + 2 < nk) gload(kt + 2);
    __syncthreads();
    step(As1, Bs1, As0, Bs0, kt + 2 < nk);
    if (kt + 3 < nk) gload(kt + 3);
    __syncthreads();
  }
#pragma unroll
  for (int i = 0; i < 4; ++i)
#pragma unroll
    for (int j = 0; j < 2; ++j)
#pragma unroll
      for (int r = 0; r < 16; ++r) {
        const int row = m0 + 128 * wm + 32 * i + crow(r, h);
        const int col = n0 + 64 * wn + 32 * j + l31;
        if (MODE == 0) ((u16*)outp)[(size_t)row * LDP + col] = f2bf(acc[i][j][r]);
        else ((u16*)outp)[(size_t)row * 2048 + col] = f2bf(acc[i][j][r]);
      }
}

template <bool PASS_C>
DI void gla_item(const Params& p, int slice, int item, char* smem, bool dry = false) {
  u16* Qs = (u16*)smem;
  u16* Ks = Qs + 64 * 136;
  u16* KTs = Ks + 64 * 136;
  u16* VTs = KTs + 128 * 72;
  float* LRs = (float*)(VTs + 256 * 72);
  float* TOT = LRs + 64 * 16;
  float* EB = TOT + 4 * 128;
  float* BL = EB + 128;
  float* WS = BL + 64 * 128;
  const int tid = otid(), lane = tid & 63, w = tid >> 6, h = lane >> 5, l31 = lane & 31;
  const int dir = item & 1, hh = (item >> 1) & 3, sg = item >> 3;
  const int d = tid & 127, tg = tid >> 7;
  const u16* proj = p.proj;
  const float* gw = dir ? p.gw_b : p.gw_f;
  const float* gb = dir ? p.gb_b : p.gb_f;
  u16* WTb = (u16*)WS;
  u16* LRb = (u16*)LRs;
#pragma unroll
  for (int i = 0; i < 4; ++i) { const int e = tid + 512 * i; const int dd = e >> 4, r = e & 15; WTb[e] = f2bf(gw[r * 512 + hh * 128 + dd]); }
  const float bias_z = gb[hh * 128 + 32 * (w >> 1) + l31];
  f32x16 S[4];
  float* Uit = p.U + (size_t)item * 32768;
#pragma unroll
  for (int dt = 0; dt < 4; ++dt)
#pragma unroll
    for (int r = 0; r < 16; ++r) S[dt][r] = PASS_C ? Uit[(dt * 16 + r) * 512 + tid] : 0.f;
  float dlog = 0.f;
  u16* odir = (u16*)(p.out + (size_t)slice * SL * DM) + (size_t)dir * SL * DM;
  const int lrcol = dir ? C_LRB : C_LRF;

  u32x4 pq[2], pk[2], pv[4], plr;
  auto gl_chunk = [&](int cc, int tid) {
    const int c = dir ? 7 - cc : cc;
    const int r0 = sg * 512 + c * 64;
#pragma unroll
    for (int i = 0; i < 2; ++i) {
      const int idx = tid + 512 * i; const int t = idx >> 4, c8 = idx & 15;
      pk[i] = *(const u32x4*)(proj + (size_t)(r0 + t) * LDP + C_GK + hh * 128 + c8 * 8);
      if (PASS_C) pq[i] = *(const u32x4*)(proj + (size_t)(r0 + t) * LDP + C_GQ + hh * 128 + c8 * 8);
    }
    if (tid < 128) plr = *(const u32x4*)(proj + (size_t)(r0 + (tid >> 1)) * LDP + lrcol + (tid & 1) * 8);
  };
  auto gl_chunk_v = [&](int cc, int tid) {
    const int c = dir ? 7 - cc : cc;
    const int r0 = sg * 512 + c * 64;
#pragma unroll
    for (int i = 0; i < 4; ++i) {
      const int idx = tid + 512 * i; const int t = idx >> 5, vg = idx & 31;
      pv[i] = *(const u32x4*)(proj + (size_t)(r0 + t) * LDP + C_GV + hh * 256 + vg * 8);
    }
  };
  gl_chunk(0, tid); gl_chunk_v(0, tid);
  const int tid_outer = tid;
  for (int cc = 0; cc < 8; ++cc) {
    int tid = tid_outer; asm volatile("" : "+v"(tid));
    const int lane = tid & 63, w = tid >> 6, h = lane >> 5, l31 = lane & 31, d = tid & 127, tg = tid >> 7;
    const int c = dir ? 7 - cc : cc;
    int row0 = sg * 512 + c * 64;
    asm volatile("" : "+s"(row0));
#pragma unroll
    for (int i = 0; i < 2; ++i) {
      const int idx = tid + 512 * i; const int t = idx >> 4, c8 = idx & 15;
      *(u32x4*)(Ks + t * 136 + c8 * 8) = pk[i];
      if (PASS_C) *(u32x4*)(Qs + t * 136 + c8 * 8) = pq[i];
    }
#pragma unroll
    for (int i = 0; i < 4; ++i) {
      const int idx = tid + 512 * i; const int t = idx >> 5, vg = idx & 31;
      *(u32x4*)(VTs + t * 288 + vg * 8) = pv[i];
    }
    if (tid < 128) *(u32x4*)(LRb + (tid >> 1) * 16 + (tid & 1) * 8) = plr;
    __syncthreads();
    if (cc + 1 < 8) { gl_chunk(cc + 1, tid); if (!PASS_C) gl_chunk_v(cc + 1, tid); }
    {
      const int ttz = w & 1, dz = 32 * (w >> 1) + l31;
      const bf16x8 az = *(const bf16x8*)(LRb + (32 * ttz + l31) * 16 + 8 * h);
      const bf16x8 bz = *(const bf16x8*)(WTb + dz * 16 + 8 * h);
      f32x16 z;
#pragma unroll
      for (int r = 0; r < 16; ++r) z[r] = 0.f;
      z = MFMA32(az, bz, z);
      float la[16];
#pragma unroll
      for (int r = 0; r < 16; ++r) la[r] = z[r] + bias_z;
      float ex[16];
#pragma unroll
      for (int r = 0; r < 16; ++r) ex[r] = __builtin_amdgcn_exp2f(-fabsf(la[r]) * 1.4426950408889634f);
#pragma unroll
      for (int r = 0; r < 16; ++r) ex[r] = __builtin_amdgcn_logf(1.f + ex[r]);
#pragma unroll
      for (int r = 0; r < 16; ++r) la[r] = (fminf(la[r], 0.f) - 0.6931471805599453f * ex[r]) * (1.f / 16.f);
      float G[4];
#pragma unroll
      for (int g = 0; g < 4; ++g) {
        if (dir) { la[4*g+2] += la[4*g+3]; la[4*g+1] += la[4*g+2]; la[4*g] += la[4*g+1]; G[g] = la[4*g]; }
        else     { la[4*g+1] += la[4*g];   la[4*g+2] += la[4*g+1]; la[4*g+3] += la[4*g+2]; G[g] = la[4*g+3]; }
      }
      float Go[4];
#pragma unroll
      for (int g = 0; g < 4; ++g) Go[g] = __shfl_xor(G[g], 32, 64);
      float base[4]; float runp = 0.f;
      if (dir) {
#pragma unroll
        for (int g = 3; g >= 0; --g) { base[g] = runp + (h == 0 ? Go[g] : 0.f); runp += G[g] + Go[g]; }
      } else {
#pragma unroll
        for (int g = 0; g < 4; ++g) { base[g] = runp + (h == 1 ? Go[g] : 0.f); runp += G[g] + Go[g]; }
      }
#pragma unroll
      for (int g = 0; g < 4; ++g)
#pragma unroll
        for (int r4 = 0; r4 < 4; ++r4) BL[(32 * ttz + 8 * g + 4 * h + r4) * 128 + dz] = la[4 * g + r4] + base[g];
      if (h == 0) TOT[ttz * 128 + dz] = runp;
    }
    __syncthreads();
    const float tot0 = TOT[d], tot1 = TOT[128 + d];
    const float all = tot0 + tot1;
    const float pre = dir ? ((tg < 2) ? tot1 : 0.f) : ((tg >= 2) ? tot0 : 0.f);
    {
      float bb[16], kv[16], qv[16];
#pragma unroll
      for (int u = 0; u < 16; ++u) {
        const int t = 16 * tg + u;
        bb[u] = BL[t * 128 + d] + pre;
        kv[u] = bf2f(Ks[t * 136 + d]);
        if (PASS_C) qv[u] = bf2f(Qs[t * 136 + d]);
      }
      float eb[16];
#pragma unroll
      for (int u = 0; u < 16; ++u) eb[u] = __builtin_amdgcn_exp2f(bb[u] * 1.4426950408889634f);
      unsigned kp[8];
#pragma unroll
      for (int i2 = 0; i2 < 8; ++i2) {
        kp[i2] = pack2(kv[2 * i2] * __builtin_amdgcn_rcpf(eb[2 * i2]), kv[2 * i2 + 1] * __builtin_amdgcn_rcpf(eb[2 * i2 + 1]));
        if (PASS_C) {
          const unsigned qp = pack2(qv[2 * i2] * eb[2 * i2], qv[2 * i2 + 1] * eb[2 * i2 + 1]);
          Ks[(16 * tg + 2 * i2) * 136 + d] = (u16)(kp[i2] & 0xffffu);
          Ks[(16 * tg + 2 * i2 + 1) * 136 + d] = (u16)(kp[i2] >> 16);
          Qs[(16 * tg + 2 * i2) * 136 + d] = (u16)(qp & 0xffffu);
          Qs[(16 * tg + 2 * i2 + 1) * 136 + d] = (u16)(qp >> 16);
        }
      }
      u32x4 k0, k1;
      k0[0] = kp[0]; k0[1] = kp[1]; k0[2] = kp[2]; k0[3] = kp[3];
      k1[0] = kp[4]; k1[1] = kp[5]; k1[2] = kp[6]; k1[3] = kp[7];
      *(u32x4*)(KTs + d * 72 + 16 * tg) = k0;
      *(u32x4*)(KTs + d * 72 + 16 * tg + 8) = k1;
    }
    if (tg == 0) { EB[d] = __expf(all); dlog += all; }
    __syncthreads();

    if (PASS_C) {
      f32x16 X00, X11, Xoff;
#pragma unroll
      for (int r = 0; r < 16; ++r) { X00[r] = 0.f; X11[r] = 0.f; Xoff[r] = 0.f; }
#pragma unroll 2
      for (int s = 0; s < 8; ++s) {
        bf16x8 a0 = *(const bf16x8*)(Ks + l31 * 136 + 16 * s + 8 * h);
        bf16x8 a1 = *(const bf16x8*)(Ks + (32 + l31) * 136 + 16 * s + 8 * h);
        bf16x8 b0 = *(const bf16x8*)(Qs + l31 * 136 + 16 * s + 8 * h);
        bf16x8 b1 = *(const bf16x8*)(Qs + (32 + l31) * 136 + 16 * s + 8 * h);
        X00 = MFMA32(a0, b0, X00);
        X11 = MFMA32(a1, b1, X11);
        bf16x8 ao = dir ? a1 : a0, bo = dir ? b0 : b1;
        Xoff = MFMA32(ao, bo, Xoff);
      }
      {
        int lo = l31 - 4 * h;
        asm volatile("" : "+v"(lo));
#pragma unroll
        for (int r = 0; r < 16; ++r) {
          const int j = (r & 3) + 8 * (r >> 2);
          const bool keep = dir ? (j >= lo) : (j <= lo);
          X00[r] = keep ? X00[r] : 0.f; X11[r] = keep ? X11[r] : 0.f;
        }
      }
      const bf16x8 x00a = pack8<0>(X00), x00b = pack8<1>(X00), x11a = pack8<0>(X11), x11b = pack8<1>(X11),
                   xofa = pack8<0>(Xoff), xofb = pack8<1>(Xoff);
      const bf16x8 vp00 = tr_frag(VTs, 288, 32 * w, 0 + 4 * h, 8 + 4 * h, lane), vp01 = tr_frag(VTs, 288, 32 * w, 16 + 4 * h, 24 + 4 * h, lane),
                   vp10 = tr_frag(VTs, 288, 32 * w, 32 + 4 * h, 40 + 4 * h, lane), vp11 = tr_frag(VTs, 288, 32 * w, 48 + 4 * h, 56 + 4 * h, lane);
#pragma unroll
      for (int it = 0; it < 2; ++it) {
        f32x16 acc;
#pragma unroll
        for (int r = 0; r < 16; ++r) acc[r] = 0.f;
        const u16* qrow = Qs + (32 * it + l31) * 136;
#pragma unroll
        for (int dt = 0; dt < 4; ++dt) {
          acc = MFMA32(ld_perm(qrow + 32 * dt, 0, h), pack8<0>(S[dt]), acc);
          acc = MFMA32(ld_perm(qrow + 32 * dt, 1, h), pack8<1>(S[dt]), acc);
        }
        if (it == 0) {
          acc = MFMA32(x00a, vp00, acc);
          acc = MFMA32(x00b, vp01, acc);
          if (dir) {
            acc = MFMA32(xofa, vp10, acc);
            acc = MFMA32(xofb, vp11, acc);
          }
        } else {
          acc = MFMA32(x11a, vp10, acc);
          acc = MFMA32(x11b, vp11, acc);
          if (!dir) {
            acc = MFMA32(xofa, vp00, acc);
            acc = MFMA32(xofb, vp01, acc);
          }
        }
#pragma unroll
        for (int r = 0; r < 16; ++r)
          if (!dry) odir[(size_t)(row0 + 32 * it + crow(r, h)) * DM + hh * 256 + 32 * w + l31] = f2bf(acc[r]);
      }
    }
    if (PASS_C && cc + 1 < 8) gl_chunk_v(cc + 1, tid);
    bf16x8 vb[4];
#pragma unroll
    for (int ks = 0; ks < 4; ++ks) vb[ks] = tr_frag(VTs, 288, 32 * w, 16 * ks + 8 * h, 16 * ks + 8 * h + 4, lane);
#pragma unroll
    for (int dt = 0; dt < 4; ++dt) {
#pragma unroll
      for (int ks = 0; ks < 4; ++ks) {
        bf16x8 a = *(const bf16x8*)(KTs + (32 * dt + l31) * 72 + 16 * ks + 8 * h);
        S[dt] = MFMA32(a, vb[ks], S[dt]);
      }
#pragma unroll
      for (int g = 0; g < 4; ++g) {
        f32x4 e = *(const f32x4*)(EB + 32 * dt + 8 * g + 4 * h);
        S[dt][4 * g + 0] *= e[0]; S[dt][4 * g + 1] *= e[1]; S[dt][4 * g + 2] *= e[2]; S[dt][4 * g + 3] *= e[3];
      }
    }
    __syncthreads();
  }
  if (!PASS_C) {
#pragma unroll
    for (int dt = 0; dt < 4; ++dt)
#pragma unroll
      for (int r = 0; r < 16; ++r) Uit[(dt * 16 + r) * 512 + tid] = S[dt][r];
    if (tg == 0) p.Dlog[item * 128 + d] = dlog;
  }
}

DI void gla_pass_b(const Params& p, int slice) {
  const int nseq = slice == 0 ? 1 : 2, segs = slice == 0 ? 32 : 16;
  const int total = nseq * 8 * 32768;
  for (int e = blockIdx.x * NT + otid(); e < total; e += gridDim.x * NT) {
    const int elem = e & 32767, hd = (e >> 15) & 7, sq = e >> 18;
    const int dir = hd & 1;
    const int t = elem & 511, dtreg = elem >> 9;
    const int hl = (t & 63) >> 5;
    const int d = 32 * (dtreg >> 4) + crow(dtreg & 15, hl);
    float carry = 0.f;
    for (int i0 = 0; i0 < segs; i0 += 16) {
      float u[16], dl[16];
#pragma unroll
      for (int k = 0; k < 16; ++k) {
        const int sgl = dir ? segs - 1 - (i0 + k) : (i0 + k);
        const int it = (sq * segs + sgl) * 8 + hd;
        u[k] = p.U[(size_t)it * 32768 + elem];
        dl[k] = p.Dlog[it * 128 + d];
      }
#pragma unroll
      for (int k = 0; k < 16; ++k) {
        const int sgl = dir ? segs - 1 - (i0 + k) : (i0 + k);
        const int it = (sq * segs + sgl) * 8 + hd;
        p.U[(size_t)it * 32768 + elem] = carry;
        carry = __expf(dl[k]) * carry + u[k];
      }
    }
  }
}

DI void gla_combine(const Params& p, int slice) {
  const int lane = otid() & 63, w = otid() >> 6;
  const int nw = gridDim.x * (NT / 64);
  const u16* of = (const u16*)(p.out + (size_t)slice * SL * DM);
  const u16* ob = of + (size_t)SL * DM;
  const int col = (lane >> 4) * 256 + (lane & 15) * 16;
  float ng[16];
#pragma unroll
  for (int i = 0; i < 4; ++i) { f32x4 t4 = *(const f32x4*)(p.gla_ng + (lane & 15) * 16 + 4 * i); ng[4*i] = t4[0]; ng[4*i+1] = t4[1]; ng[4*i+2] = t4[2]; ng[4*i+3] = t4[3]; }
  for (int row0 = (blockIdx.x * (NT / 64) + w) * 4; row0 < SL; row0 += nw * 4) {
    bf16x8 a0[4], a1[4], b0[4], b1[4], g0[4], g1[4];
#pragma unroll
    for (int u = 0; u < 4; ++u) {
      const int row = row0 + u;
      a0[u] = *(const bf16x8*)(of + (size_t)row * DM + col); a1[u] = *(const bf16x8*)(of + (size_t)row * DM + col + 8);
      b0[u] = *(const bf16x8*)(ob + (size_t)row * DM + col); b1[u] = *(const bf16x8*)(ob + (size_t)row * DM + col + 8);
      const u16* gp = p.proj + (size_t)row * LDP + C_GG + col;
      g0[u] = *(const bf16x8*)gp; g1[u] = *(const bf16x8*)(gp + 8);
    }
#pragma unroll
    for (int u = 0; u < 4; ++u) {
      u16* gp = p.proj + (size_t)(row0 + u) * LDP + C_GG + col;
      float o[16]; float ss = 0.f;
#pragma unroll
      for (int i = 0; i < 8; ++i) {
        o[i] = bf2f((u16)a0[u][i]) + bf2f((u16)b0[u][i]); o[8 + i] = bf2f((u16)a1[u][i]) + bf2f((u16)b1[u][i]);
        ss += o[i] * o[i] + o[8 + i] * o[8 + i];
      }
#pragma unroll
      for (int m = 8; m > 0; m >>= 1) ss += __shfl_xor(ss, m, 64);
      const float rstd = rsqrtf(ss * (1.f / 256.f) + 1e-6f);
      u32x4 r0, r1;
#pragma unroll
      for (int i = 0; i < 4; ++i) {
        r0[i] = pack2(o[2*i] * rstd * ng[2*i] * silu(bf2f((u16)g0[u][2*i])), o[2*i+1] * rstd * ng[2*i+1] * silu(bf2f((u16)g0[u][2*i+1])));
        r1[i] = pack2(o[8+2*i] * rstd * ng[8+2*i] * silu(bf2f((u16)g1[u][2*i])), o[8+2*i+1] * rstd * ng[8+2*i+1] * silu(bf2f((u16)g1[u][2*i+1])));
      }
      *(u32x4*)gp = r0; *(u32x4*)(gp + 8) = r1;
    }
  }
}

DI void nat_item(const Params& p, int slice, int item, char* smem, bool dry = false) {
  const int tid = otid(), lane = tid & 63, w = tid >> 6, h = lane >> 5, l31 = lane & 31;
  u16* VT = (u16*)smem + w * (64 * 96);
  float* SC = (float*)(smem + 8 * 64 * 96 * 2) + w * 64;
  float* BIAS = (float*)(smem + 8 * 64 * 96 * 2 + 8 * 64 * 4) + w * 480;
  const int nh = item & 7, R = item >> 3;
  const int rows = slice == 0 ? 256 : 128;
  const int sq = R / rows, r = R % rows;
  const int rs = min(max(r - 4, 0), rows - 8);
  const int seq0 = sq * rows * 64;
  const int qrow0 = seq0 + r * 64;
  u16* proj = p.proj;
  for (int i = lane; i < 465; i += 64) BIAS[i] = p.rpb[nh * 465 + i];
  bf16x8 bq[2][4];
#pragma unroll
  for (int qt = 0; qt < 2; ++qt)
#pragma unroll
    for (int s = 0; s < 4; ++s) bq[qt][s] = *(const bf16x8*)(proj + (size_t)(qrow0 + 32 * qt + l31) * LDP + C_NQ + nh * 64 + 16 * s + 8 * h);
  f32x16 o[2][2];
#pragma unroll
  for (int a = 0; a < 2; ++a)
#pragma unroll
    for (int b = 0; b < 2; ++b)
#pragma unroll
      for (int rr = 0; rr < 16; ++rr) o[a][b][rr] = 0.f;
  float mrun[2] = {-1e30f, -1e30f}, lrun[2] = {0.f, 0.f};
  unsigned vmask[2];
#pragma unroll
  for (int qt = 0; qt < 2; ++qt) {
    const int cq = 32 * qt + l31;
    const int cs = min(max(cq - 8, 0), 48);
    unsigned m = 0u;
#pragma unroll
    for (int kt = 0; kt < 2; ++kt)
#pragma unroll
      for (int rr = 0; rr < 16; ++rr) {
        const int ck = 32 * kt + crow(rr, h);
        m |= ((ck >= cs) && (ck < cs + 16)) ? (1u << (kt * 16 + rr)) : 0u;
      }
    vmask[qt] = m;
  }
  bf16x8 ka[2][4]; u32x4 vc[8];
  auto ld_row = [&](int kk, bf16x8 (&kf)[2][4], u32x4 (&vr)[8]) {
    const int kr0 = seq0 + (rs + kk) * 64;
#pragma unroll
    for (int i = 0; i < 8; ++i) {
      const int idx = lane + 64 * i; const int key = idx >> 3, dg = idx & 7;
      vr[i] = *(const u32x4*)(proj + (size_t)(kr0 + key) * LDP + C_NV + nh * 64 + dg * 8);
    }
#pragma unroll
    for (int kt = 0; kt < 2; ++kt)
#pragma unroll
      for (int s = 0; s < 4; ++s) kf[kt][s] = *(const bf16x8*)(proj + (size_t)(kr0 + 32 * kt + l31) * LDP + C_NK + nh * 64 + 16 * s + 8 * h);
  };
#pragma unroll 1
  for (int kk = 0; kk < 8; ++kk) {
    ld_row(kk, ka, vc);
#pragma unroll
    for (int i = 0; i < 8; ++i) {
      const int idx = lane + 64 * i; const int key = idx >> 3, dg = idx & 7;
      *(u32x4*)(VT + key * 96 + dg * 8) = vc[i];
    }
    f32x16 acc[2][2];
#pragma unroll
    for (int a = 0; a < 2; ++a)
#pragma unroll
      for (int b = 0; b < 2; ++b)
#pragma unroll
        for (int rr = 0; rr < 16; ++rr) acc[a][b][rr] = 0.f;
#pragma unroll
    for (int s = 0; s < 4; ++s)
#pragma unroll
      for (int kt = 0; kt < 2; ++kt)
#pragma unroll
        for (int qt = 0; qt < 2; ++qt) acc[kt][qt] = MFMA32(ka[kt][s], bq[qt][s], acc[kt][qt]);
    const int drow = rs + kk - r + 7;
#pragma unroll
    for (int qt = 0; qt < 2; ++qt) {
      const int cq = 32 * qt + l31;
      const float* bp = BIAS + drow * 31 + (15 - cq + 4 * h);
      float mx = -1e30f;
#pragma unroll
      for (int kt = 0; kt < 2; ++kt)
#pragma unroll
        for (int rr = 0; rr < 16; ++rr) {
          const float sc = acc[kt][qt][rr] + bp[32 * kt + (rr & 3) + 8 * (rr >> 2)];
          acc[kt][qt][rr] = ((vmask[qt] >> (kt * 16 + rr)) & 1u) ? sc : -1e30f;
          mx = fmaxf(mx, acc[kt][qt][rr]);
        }
      mx = fmaxf(mx, __shfl_xor(mx, 32, 64));
      const float mnew = fmaxf(mrun[qt], mx);
      const float alpha = __expf(mrun[qt] - mnew);
      mrun[qt] = mnew;
      float ls = 0.f;
#pragma unroll
      for (int kt = 0; kt < 2; ++kt)
#pragma unroll
        for (int rr = 0; rr < 16; ++rr) { float e = __expf(acc[kt][qt][rr] - mnew); acc[kt][qt][rr] = e; ls += e; }
      ls += __shfl_xor(ls, 32, 64);
      lrun[qt] = lrun[qt] * alpha + ls;
#pragma unroll
      for (int dt = 0; dt < 2; ++dt)
#pragma unroll
        for (int rr = 0; rr < 16; ++rr) o[qt][dt][rr] *= alpha;
    }
    bf16x8 vf[2][4];
#pragma unroll
    for (int dt = 0; dt < 2; ++dt) {
      vf[dt][0] = tr_frag(VT, 96, 32 * dt, 0 + 4 * h, 8 + 4 * h, lane);   vf[dt][1] = tr_frag(VT, 96, 32 * dt, 16 + 4 * h, 24 + 4 * h, lane);
      vf[dt][2] = tr_frag(VT, 96, 32 * dt, 32 + 4 * h, 40 + 4 * h, lane); vf[dt][3] = tr_frag(VT, 96, 32 * dt, 48 + 4 * h, 56 + 4 * h, lane);
    }
#pragma unroll
    for (int qt = 0; qt < 2; ++qt) {
      const bf16x8 p00 = pack8<0>(acc[0][qt]), p01 = pack8<1>(acc[0][qt]), p10 = pack8<0>(acc[1][qt]), p11 = pack8<1>(acc[1][qt]);
#pragma unroll
      for (int dt = 0; dt < 2; ++dt) {
        o[qt][dt] = MFMA32(vf[dt][0], p00, o[qt][dt]);
        o[qt][dt] = MFMA32(vf[dt][1], p01, o[qt][dt]);
        o[qt][dt] = MFMA32(vf[dt][2], p10, o[qt][dt]);
        o[qt][dt] = MFMA32(vf[dt][3], p11, o[qt][dt]);
      }
    }
  }
#pragma unroll
  for (int qt = 0; qt < 2; ++qt) {
    const float inv = 1.f / lrun[qt];
    u16* rowp = proj + (size_t)(qrow0 + 32 * qt + l31) * LDP + C_NG + nh * 64;
#pragma unroll
    for (int dt = 0; dt < 2; ++dt)
#pragma unroll
      for (int g = 0; g < 4; ++g) {
        u16* gp = rowp + 32 * dt + 8 * g + 4 * h;
        const bf16x4 gt = *(const bf16x4*)gp;
        u32x2 res;
        res[0] = pack2(o[qt][dt][4 * g + 0] * inv * silu(bf2f((u16)gt[0])), o[qt][dt][4 * g + 1] * inv * silu(bf2f((u16)gt[1])));
        res[1] = pack2(o[qt][dt][4 * g + 2] * inv * silu(bf2f((u16)gt[2])), o[qt][dt][4 * g + 3] * inv * silu(bf2f((u16)gt[3])));
        if (!dry) *(u32x2*)gp = res;
      }
  }
}

DI void mem_item(const Params& p, int slice, int item, char* smem, bool dry = false) {
  const int tid = otid(), lane = tid & 63, w = tid >> 6, h = lane >> 5, l31 = lane & 31;
  u16* VT = (u16*)smem;
  u16* KM = VT + 256 * 144;
  const int mh = item & 3, tb = item >> 2;
  const int batch = slice == 0 ? 0 : (tb < 32 ? 1 : 2);
  const u16* mkv = p.mkv + (size_t)batch * 256 * 1024;
  u16* proj = p.proj;
#pragma unroll
  for (int i = 0; i < 8; ++i) {
    int idx = tid + 512 * i; int key = idx >> 4, dg = idx & 15;
    *(u32x4*)(VT + key * 144 + dg * 8) = *(const u32x4*)(mkv + (size_t)key * 1024 + 512 + mh * 128 + dg * 8);
    *(u32x4*)(KM + key * 136 + dg * 8) = *(const u32x4*)(mkv + (size_t)key * 1024 + mh * 128 + dg * 8);
  }
  const int qrow = tb * 256 + 32 * w + l31;
  bf16x8 bq[8];
#pragma unroll
  for (int s = 0; s < 8; ++s) bq[s] = *(const bf16x8*)(proj + (size_t)qrow * LDP + C_MQ + mh * 128 + 16 * s + 8 * h);
  float* LB = (float*)(smem + 256 * 144 * 2 + 256 * 136 * 2) + w * 32;
  float m = -1e30f;
  __syncthreads();
#pragma unroll 1
  for (int kt = 0; kt < 8; ++kt) {
    f32x16 acc;
#pragma unroll
    for (int rr = 0; rr < 16; ++rr) acc[rr] = 0.f;
#pragma unroll
    for (int s = 0; s < 8; ++s) {
      bf16x8 a = *(const bf16x8*)(KM + (32 * kt + l31) * 136 + 16 * s + 8 * h);
      acc = MFMA32(a, bq[s], acc);
    }
#pragma unroll
    for (int rr = 0; rr < 16; ++rr) m = fmaxf(m, acc[rr]);
  }
  m = fmaxf(m, __shfl_xor(m, 32, 64));
  f32x16 o[4];
#pragma unroll
  for (int dt = 0; dt < 4; ++dt)
#pragma unroll
    for (int rr = 0; rr < 16; ++rr) o[dt][rr] = 0.f;
  float l = 0.f;
#pragma unroll 1
  for (int kt = 0; kt < 8; ++kt) {
    f32x16 acc;
#pragma unroll
    for (int rr = 0; rr < 16; ++rr) acc[rr] = 0.f;
#pragma unroll
    for (int s = 0; s < 8; ++s) {
      bf16x8 a = *(const bf16x8*)(KM + (32 * kt + l31) * 136 + 16 * s + 8 * h);
      acc = MFMA32(a, bq[s], acc);
    }
#pragma unroll
    for (int rr = 0; rr < 16; ++rr) { float e = __expf(acc[rr] - m); acc[rr] = e; l += e; }
    const bf16x8 p0 = pack8<0>(acc), p1 = pack8<1>(acc);
#pragma unroll
    for (int dt = 0; dt < 4; ++dt) {
      o[dt] = MFMA32(tr_frag(VT, 144, 32 * dt, 32 * kt + 4 * h, 32 * kt + 8 + 4 * h, lane), p0, o[dt]);
      o[dt] = MFMA32(tr_frag(VT, 144, 32 * dt, 32 * kt + 16 + 4 * h, 32 * kt + 24 + 4 * h, lane), p1, o[dt]);
    }
  }
  l += __shfl_xor(l, 32, 64);
  {
    const float inv = 1.f / l;
    u16* rowp = proj + (size_t)(tb * 256 + 32 * w + l31) * LDP + C_MG + mh * 128;
#pragma unroll
    for (int dt = 0; dt < 4; ++dt)
#pragma unroll
      for (int g = 0; g < 4; ++g) {
        u16* gp = rowp + 32 * dt + 8 * g + 4 * h;
        const bf16x4 gt = *(const bf16x4*)gp;
        u32x2 res;
        res[0] = pack2(o[dt][4 * g + 0] * inv * silu(bf2f((u16)gt[0])), o[dt][4 * g + 1] * inv * silu(bf2f((u16)gt[1])));
        res[1] = pack2(o[dt][4 * g + 2] * inv * silu(bf2f((u16)gt[2])), o[dt][4 * g + 3] * inv * silu(bf2f((u16)gt[3])));
        if (!dry) *(u32x2*)gp = res;
      }
  }
  __syncthreads();
}

DI void final_norm(const Params& p, int slice, int wi, int wc) {
  const int lane = otid() & 63, w = otid() >> 6;
  const int nw = wc * (NT / 64);
  f32x4 g[4];
#pragma unroll
  for (int i = 0; i < 4; ++i) g[i] = *(const f32x4*)(p.post_g + (i * 64 + lane) * 4);
  for (int r0 = (wi * (NT / 64) + w) * 4; r0 < SL; r0 += nw * 4) {
    bf16x4 vb[4][4]; f32x4 xq[4][4];
#pragma unroll
    for (int u = 0; u < 4; ++u) {
      const u16* o = (const u16*)(p.out + ((size_t)slice * SL + r0 + u) * DM);
      const float* xs = p.x[slice] + (size_t)(r0 + u) * DM;
#pragma unroll
      for (int i = 0; i < 4; ++i) { vb[u][i] = __builtin_nontemporal_load((const bf16x4*)(o + (i * 64 + lane) * 4)); xq[u][i] = __builtin_nontemporal_load((const f32x4*)(xs + (i * 64 + lane) * 4)); }
    }
    float rstd[4];
#pragma unroll
    for (int u = 0; u < 4; ++u) {
      float ss = 0.f;
#pragma unroll
      for (int i = 0; i < 4; ++i)
#pragma unroll
        for (int c = 0; c < 4; ++c) { const float v = bf2f((u16)vb[u][i][c]); ss += v * v; }
      ss = wave_sum(ss);
      rstd[u] = rsqrtf(ss * (1.f / DM) + 1e-6f);
    }
#pragma unroll
    for (int u = 0; u < 4; ++u) {
      float* o = p.out + ((size_t)slice * SL + r0 + u) * DM;
#pragma unroll
      for (int i = 0; i < 4; ++i) {
        f32x4 y;
#pragma unroll
        for (int c = 0; c < 4; ++c) y[c] = xq[u][i][c] + bf2f((u16)vb[u][i][c]) * rstd[u] * g[i][c];
        __builtin_nontemporal_store(y, (f32x4*)(o + (i * 64 + lane) * 4));
      }
    }
  }
}

DI int xq(int v, int G, int& x) { const int b = v % G, i = v / G; x = b & 7; return (b >> 3) + (G >> 3) * i; }
DI void map_p1(int v, int G, int& m, int& n) {
  if (G != 256) { m = v / 49; n = v % 49; return; }
  int x; const int q = xq(v, G, x);
  if (q >= 392) { m = -1; n = 0; return; }
  const int mh = q / 196, rem = q % 196;
  n = rem >> 2; m = 8 * x + 4 * mh + (rem & 3);
}
DI void map_out(int v, int G, int& m, int& n) {
  if (G != 256) { m = v / 8; n = v % 8; return; }
  int x; const int q = xq(v, G, x);
  if (q >= 64) { m = -1; n = 0; return; }
  n = (q >> 2) & 7; m = 8 * x + 4 * (q >> 5) + (q & 3);
}
DI void map_p1_big(int v, int G, int& m, int& n) {
  if (G != 256) { m = v / 24; n = v % 24; return; }
  int x; const int q = xq(v, G, x);
  if (q >= 192) { m = -1; n = 0; return; }
  n = q >> 3; m = 8 * x + (q & 7);
}
DI void map_out_big(int v, int G, int& m, int& n) {
  if (G != 256) { m = v / 4; n = v % 4; return; }
  int x; const int q = xq(v, G, x);
  if (q >= 32) { m = -1; n = 0; return; }
  n = (q >> 2) & 3; m = 8 * x + 4 * (q >> 4) + (q & 3);
}
DI int map_gla(int v, int G) {
  if (G != 256) return v;
  int x; const int q = xq(v, G, x);
  if (q >= 32) return -1;
  return (4 * x + (q >> 3)) * 8 + (q & 7);
}
DI int map_natrow(int v, int G) {
  if (G != 256) return v;
  int x; const int q = xq(v, G, x);
  if (q >= 32) return -1;
  return 32 * x + q;
}
#define GSYNC() do { xcd_barrier(xb); if (DUP & 64) xcd_barrier(xb); } while (0)
__global__ void __launch_bounds__(NT) mega_kernel(Params p) {
  __shared__ __attribute__((aligned(16))) char smem[SMEM_BYTES];
  __shared__ uint4 xb_words;
  cg::grid_group grid = cg::this_grid();
  const int G = gridDim.x, B = blockIdx.x;
  if (threadIdx.x == 0) xb_words = make_uint4(0u, 0u, 0u, 0u);
  __syncthreads();
  const XcdBarrier xb = xcd_barrier_post(p.bar, (volatile LAS unsigned*)&xb_words);

  if (PH & 1) phase0(p, smem);
  if (DUP & 32) phase0(p, smem);
  if (p.use_cg_sync) grid.sync(); else GSYNC();
#pragma unroll 1
  for (int s = 0; s < 2; ++s) {
    {
      const u16* hA = (const u16*)(p.out + (size_t)s * SL * DM);
      if (PH & 2) {
        const int w_lo = (G == 256) ? (s == 0 ? 88 : 64) : 0;
        const int wi = B - w_lo, wc = G - w_lo;
        const int extra_at = (B >> 3) % 6; int ti = 0; bool extra_done = (wi < 0);
        for (int rp = 1; rp < p.rep_p1; ++rp)
          for (int t = B; t < 64 * 24; t += G) { int m, n; map_p1_big(t, G, m, n); if (m < 0 || m >= 64) break; gemm_tile_big<0>(hA, DM, p.wt_in, 1024, m * 256, n * 256, p.proj, smem); }
        for (int t = B; t < 64 * 24; t += G, ++ti) {
          if (ti == extra_at && !extra_done) { if (s == 0) { prep_rows(p, SL, 2 * SL, wi, wc); prep_wout(p, smem, wi, wc); } else if (PH & 8) final_norm(p, 0, wi, wc); extra_done = true; }
          int m, n; map_p1_big(t, G, m, n); if (m < 0 || m >= 64) break; gemm_tile_big<0>(hA, DM, p.wt_in, 1024, m * 256, n * 256, p.proj, smem);
        }
        if (!extra_done) { if (s == 0) { prep_rows(p, SL, 2 * SL, wi, wc); prep_wout(p, smem, wi, wc); } else if (PH & 8) final_norm(p, 0, wi, wc); }
        for (int t = B; t < 64; t += G) gemm_tile<0>(hA, DM, p.wt_in, 1024, t * 256, 6144, p.proj, smem);
      }
      if (DUP & 8) {
        for (int t = B; t < 64 * 24; t += G) { int m, n; map_p1_big(t, G, m, n); if (m < 0 || m >= 64) break; gemm_tile_big<0>(hA, DM, p.wt_in, 1024, m * 256, n * 256, p.proj, smem); }
        for (int t = B; t < 64; t += G) gemm_tile<0>(hA, DM, p.wt_in, 1024, t * 256, 6144, p.proj, smem);
      }
      if (s == 0) {
        if (PH & 4) for (int t = (B >= 64 ? B - 64 : B + G - 64); t < 3 * 8; t += G) gemm_tile<1>(p.hm, DM, p.wt_kv, 1024, (t / 8) * 256, (t % 8) * 128, p.mkv, smem);
      }
    }
    GSYNC();
    if (PH & 16) for (int t = B; t < 256; t += G) { const int it = map_gla(t, G); if (it < 0) break; gla_item<false>(p, s, it, smem); }
    if (DUP & (1 | 256)) for (int t = B; t < 256; t += G) { const int it = map_gla(t, G); if (it < 0) break; gla_item<false>(p, s, it, smem); }
    if (DUP & 2) for (int t = B; t < 256; t += G) { const int R = map_natrow(t, G); if (R < 0) break; nat_item(p, s, R * 8 + (otid() >> 6), smem, p.dry != 0); }
    if (PH & 32) { for (int t = B; t < 256; t += G) { const int R = map_natrow(t, G); if (R < 0) break; nat_item(p, s, R * 8 + (otid() >> 6), smem); } __syncthreads(); }
    if (DUP & 4) for (int t = B; t < 256; t += G) mem_item(p, s, t, smem, p.dry != 0);
    if (PH & 64) for (int t = B; t < 256; t += G) mem_item(p, s, t, smem);
    GSYNC();
    if (PH & 128) gla_pass_b(p, s);
    GSYNC();
    if (PH & 256) for (int t = B; t < 256; t += G) { const int it = map_gla(t, G); if (it < 0) break; gla_item<true>(p, s, it, smem); }
    if (DUP & (1 | 512)) for (int t = B; t < 256; t += G) { const int it = map_gla(t, G); if (it < 0) break; gla_item<true>(p, s, it, smem); }
    if (DUP & 1024) for (int t = B; t < 256; t += G) { const int it = map_gla(t, G); if (it < 0) break; gla_item<true>(p, s, it, smem, p.dry != 0); }
    GSYNC();
    if (PH & 512) gla_combine(p, s);
    GSYNC();
    {
      float* od = p.out + (size_t)s * SL * DM;
      if (PH & 1024) for (int t = B; t < 64 * 4; t += G) { int m, n; map_out_big(t, G, m, n); if (m < 0 || m >= 64) break; gemm_tile_big<2>(p.proj, LDP, p.wt_out, 2048, m * 256, n * 256, od, smem); }
      if (DUP & 16) for (int t = B; t < 64 * 4; t += G) { int m, n; map_out_big(t, G, m, n); if (m < 0 || m >= 64) break; gemm_tile_big<2>(p.proj, LDP, p.wt_out, 2048, m * 256, n * 256, od, smem); }
    }
    GSYNC();
  }
  if (PH & 8) final_norm(p, 1, B, G);
}

extern "C" void kernel_launch(void* const* d_in, const int* in_sizes, int n_in, void* d_out, int out_size, void* d_ws,
                              size_t ws_size, hipStream_t stream) {
  static int grid_blocks = 0;
  if (!grid_blocks) {
    int dev = 0, cus = 0, per_cu = 0;
    hipGetDevice(&dev);
    hipDeviceGetAttribute(&cus, hipDeviceAttributeMultiprocessorCount, dev);
    hipOccupancyMaxActiveBlocksPerMultiprocessor(&per_cu, mega_kernel, NT, 0);
    if (per_cu < 1) per_cu = 1;
    if (per_cu > 1) per_cu = 1;
    grid_blocks = cus * per_cu;
  }
  Params p{};
  p.x[0] = (const float*)d_in[0]; p.x[1] = (const float*)d_in[1];
  p.mem[0] = (const float*)d_in[2]; p.mem[1] = (const float*)d_in[3];
  p.pre_g = (const float*)d_in[4]; p.w_in = (const float*)d_in[5];
  p.gw_f = (const float*)d_in[6]; p.gb_f = (const float*)d_in[7];
  p.gw_b = (const float*)d_in[8]; p.gb_b = (const float*)d_in[9];
  p.gla_ng = (const float*)d_in[10]; p.rpb = (const float*)d_in[11];
  p.mem_ng = (const float*)d_in[12]; p.w_kv = (const float*)d_in[13];
  p.w_out = (const float*)d_in[14]; p.post_g = (const float*)d_in[15];
  p.out = (float*)d_out;
  p.dry = 1;
  p.rep_p1 = REP_P1;
  p.use_cg_sync = 0;
  char* ws = (char*)d_ws; size_t off = 0;
  auto take = [&](size_t bytes) { char* r = ws + off; off += (bytes + 255) & ~(size_t)255; return r; };
  p.proj = (u16*)take((size_t)SL * LDP * 2);
  p.U = (float*)take((size_t)256 * 32768 * 4);
  p.Dlog = (float*)take((size_t)256 * 128 * 4);
  p.wt_in = (u16*)take((size_t)LDP * 1024 * 2);
  p.wt_kv = (u16*)take((size_t)1024 * 1024 * 2);
  p.wt_out = (u16*)take((size_t)1024 * 2048 * 2);
  p.hm = (u16*)take((size_t)768 * 1024 * 2);
  p.mkv = (u16*)take((size_t)768 * 1024 * 2);
  p.bar = (unsigned*)take((size_t)XCD_BAR_WORDS * 4);
  if (off > ws_size) { fprintf(stderr, "workspace too small: need %zu have %zu\n", off, ws_size); return; }
  hipMemsetAsync(p.bar, 0, (size_t)XCD_BAR_WORDS * 4, stream);
  void* args[] = {&p};
  hipError_t e = hipLaunchCooperativeKernel((void*)mega_kernel, dim3(grid_blocks), dim3(NT), args, 0, stream);
  if (e != hipSuccess) fprintf(stderr, "cooperative launch failed: %s (grid %d)\n", hipGetErrorString(e), grid_blocks);
}
```

```cpp
#include <hip/hip_runtime.h>
#include <hip/hip_cooperative_groups.h>
#include <cstdio>
namespace cg = cooperative_groups;

typedef unsigned short u16;
typedef __attribute__((ext_vector_type(8))) short bf16x8;
typedef __attribute__((ext_vector_type(4))) short bf16x4;
typedef __attribute__((ext_vector_type(16))) float f32x16;
typedef __attribute__((ext_vector_type(4))) float f32x4;
typedef __attribute__((ext_vector_type(4))) unsigned u32x4;
typedef __attribute__((ext_vector_type(2))) unsigned u32x2;

#define DI __device__ __forceinline__
#define MFMA32(a, b, c) __builtin_amdgcn_mfma_f32_32x32x16_bf16((a), (b), (c), 0, 0, 0)

static constexpr int NT = 512;
static constexpr int SL = 16384;
static constexpr int DM = 1024;
static constexpr int LDP = 6272;
static constexpr int C_GQ = 0, C_GK = 512, C_GV = 1024, C_GG = 2048, C_NQ = 3072, C_NK = 3584, C_NV = 4096,
                     C_NG = 4608, C_MQ = 5120, C_MG = 5632, C_LRF = 6144, C_LRB = 6160;
static constexpr int SMEM_BYTES = 144 * 1024;
#ifndef PH
#define PH 0xFFF
#endif
#ifndef DUP
#define DUP 0
#endif
#ifndef REP_P1
#define REP_P1 1
#endif

struct Params {
  const float* x[2];
  const float* mem[2];
  const float *pre_g, *w_in, *gw_f, *gb_f, *gw_b, *gb_b, *gla_ng, *rpb, *mem_ng, *w_kv, *w_out, *post_g;
  float* out;
  u16 *proj, *wt_in, *wt_kv, *wt_out, *hm, *mkv;
  float *U, *Dlog;
  unsigned* bar;
  int dry; int rep_p1; int use_cg_sync; int pad3_;
};

typedef __attribute__((ext_vector_type(2))) __bf16 bf16v2;
typedef __attribute__((ext_vector_type(2))) float f32x2;
DI unsigned pack2(float a, float b) { f32x2 v; v[0] = a; v[1] = b; return __builtin_bit_cast(unsigned, __builtin_convertvector(v, bf16v2)); }
DI u16 f2bf(float x) { return (u16)(pack2(x, 0.f) & 0xffffu); }
DI float bf2f(u16 v) { return __uint_as_float(((unsigned)v) << 16); }
DI int otid() { int t = (int)threadIdx.x; asm volatile("" : "+v"(t)); return t; }
DI int crow(int reg, int h) { return (reg & 3) + 8 * (reg >> 2) + 4 * h; }
DI float silu(float g) { return g / (1.f + __expf(-g)); }
DI float wave_sum(float v) {
#pragma unroll
  for (int o = 32; o > 0; o >>= 1) v += __shfl_xor(v, o, 64);
  return v;
}
template <int S> DI bf16x8 pack8(const f32x16& x) {
  u32x4 p;
  p[0] = pack2(x[8 * S + 0], x[8 * S + 1]); p[1] = pack2(x[8 * S + 2], x[8 * S + 3]);
  p[2] = pack2(x[8 * S + 4], x[8 * S + 5]); p[3] = pack2(x[8 * S + 6], x[8 * S + 7]);
  return __builtin_bit_cast(bf16x8, p);
}
DI bf16x8 ld_perm(const u16* rowbase, int s, int h) {
  bf16x4 lo = *(const bf16x4*)(rowbase + 16 * s + 4 * h);
  bf16x4 hi = *(const bf16x4*)(rowbase + 16 * s + 8 + 4 * h);
  return __builtin_shufflevector(lo, hi, 0, 1, 2, 3, 4, 5, 6, 7);
}


DI bf16x8 gather_nat(const u16* colp, int ld, int k0) {
  u32x4 r;
#pragma unroll
  for (int j = 0; j < 4; ++j) r[j] = (unsigned)colp[(k0 + 2 * j) * ld] | ((unsigned)colp[(k0 + 2 * j + 1) * ld] << 16);
  return __builtin_bit_cast(bf16x8, r);
}
DI bf16x8 gather_perm(const u16* colp, int ld, int kb, int s, int h) {
  const int k0 = kb + 16 * s + 4 * h;
  u32x4 r;
  r[0] = (unsigned)colp[(k0 + 0) * ld] | ((unsigned)colp[(k0 + 1) * ld] << 16);
  r[1] = (unsigned)colp[(k0 + 2) * ld] | ((unsigned)colp[(k0 + 3) * ld] << 16);
  r[2] = (unsigned)colp[(k0 + 8) * ld] | ((unsigned)colp[(k0 + 9) * ld] << 16);
  r[3] = (unsigned)colp[(k0 + 10) * ld] | ((unsigned)colp[(k0 + 11) * ld] << 16);
  return __builtin_bit_cast(bf16x8, r);
}

typedef __attribute__((ext_vector_type(4))) short s16x4;
#define LDS3 __attribute__((address_space(3)))
DI bf16x8 tr_frag(const u16* tile, int ld, int col0, int r0, int r1, int lane) {
  const int q = (lane & 15) >> 2, pcol = col0 + 16 * ((lane >> 4) & 1) + 4 * (lane & 3);
  const s16x4 lo = __builtin_amdgcn_ds_read_tr16_b64_v4i16((LDS3 s16x4*)(tile + (r0 + q) * ld + pcol));
  const s16x4 hi = __builtin_amdgcn_ds_read_tr16_b64_v4i16((LDS3 s16x4*)(tile + (r1 + q) * ld + pcol));
  return __builtin_shufflevector(lo, hi, 0, 1, 2, 3, 4, 5, 6, 7);
}

#define XB_TMO      128
#define XB_XCNT(j)  (256  + 64 * (j))
#define XB_XSUB(j)  (1280 + 64 * (j))
#define XB_XGEN(j)  (2304 + 64 * (j))
#define XB_TOP      3328
#define XB_TOPGEN   3392
#define XCD_BAR_WORDS 3456
#define XB_SPIN_CAP (1u << 18)
#define LAS __attribute__((address_space(3)))
DI unsigned xb_ld(unsigned* p)              { return __hip_atomic_load(p, __ATOMIC_RELAXED, __HIP_MEMORY_SCOPE_AGENT); }
DI unsigned xb_add(unsigned* p, unsigned v) { return __hip_atomic_fetch_add(p, v, __ATOMIC_RELAXED, __HIP_MEMORY_SCOPE_AGENT); }
DI unsigned xb_xcc_id() { return (unsigned)__builtin_amdgcn_s_getreg((3 << 11) | 20) & 0xFu; }
#define XB_SPIN(cond, bar) do { unsigned _sp = 0; while (cond) { __builtin_amdgcn_s_sleep(1); \
    if ((++_sp & 255u) == 0u) { if (xb_ld(&(bar)[XB_TMO])) break; if (_sp > XB_SPIN_CAP) { atomicAdd(&(bar)[XB_TMO], 1u); break; } } } } while (0)
struct XcdBarrier { unsigned* bar; unsigned x; volatile LAS unsigned* st; };
DI XcdBarrier xcd_barrier_post(unsigned* bar, volatile LAS unsigned* st) {
  XcdBarrier b; b.bar = bar; b.x = xb_xcc_id(); b.st = st;
  if (threadIdx.x == 0) (void)xb_add(&bar[XB_XCNT(b.x)], 1u);
  return b;
}
DI void xcd_barrier_complete(unsigned* bar, unsigned x, unsigned& nloc, unsigned& nx) {
  const unsigned G = gridDim.x * gridDim.y * gridDim.z;
  unsigned sum, cnt, mine, sp = 0u;
  for (;;) {
    sum = 0u; cnt = 0u; mine = 0u;
#pragma unroll
    for (unsigned j = 0; j < 16; ++j) { const unsigned c = xb_ld(&bar[XB_XCNT(j)]); sum += c; cnt += (c > 0u) ? 1u : 0u; mine = (j == x) ? c : mine; }
    if (sum == G) break;
    __builtin_amdgcn_s_sleep(1);
    if ((++sp & 255u) == 0u) { if (xb_ld(&bar[XB_TMO])) break; if (sp > XB_SPIN_CAP) { atomicAdd(&bar[XB_TMO], 1u); break; } }
  }
  nloc = mine > 0u ? mine : 1u; nx = cnt > 0u ? cnt : 1u;
}
DI void xcd_barrier(const XcdBarrier& b) {
  asm volatile("s_waitcnt vmcnt(0)" ::: "memory");
  __syncthreads();
  if (threadIdx.x == 0) {
    unsigned* bar = b.bar;
    __builtin_amdgcn_s_waitcnt(0);
    unsigned nloc = b.st[0], nx = b.st[1];
    if (nloc == 0u) { xcd_barrier_complete(bar, b.x, nloc, nx); b.st[0] = nloc; b.st[1] = nx; }
    const unsigned old = xb_add(&bar[XB_XSUB(b.x)], 1u);
    const unsigned gen = old / nloc;
    if (old + 1u == (gen + 1u) * nloc) {
      __builtin_amdgcn_fence(__ATOMIC_RELEASE, "agent");
      asm volatile("s_waitcnt vmcnt(0)" ::: "memory");
      const unsigned og = xb_add(&bar[XB_TOP], 1u);
      const unsigned tg = og / nx;
      if (og + 1u == (tg + 1u) * nx) xb_add(&bar[XB_TOPGEN], 1u);
      else XB_SPIN(xb_ld(&bar[XB_TOPGEN]) == tg, bar);
      __builtin_amdgcn_fence(__ATOMIC_ACQUIRE, "agent");
      xb_add(&bar[XB_XGEN(b.x)], 1u);
      asm volatile("s_waitcnt vmcnt(0)" ::: "memory");
    } else {
      XB_SPIN(xb_ld(&bar[XB_XGEN(b.x)]) == gen, bar);
      __builtin_amdgcn_fence(__ATOMIC_ACQUIRE, "agent");
      asm volatile("s_waitcnt vmcnt(0)" ::: "memory");
    }
  }
  __syncthreads();
}

DI void prep_rows(const Params& p, int row_lo, int row_hi, int wi, int wc) {
  const int lane = otid() & 63, w = otid() >> 6;
  const int nw = wc * (NT / 64);
  for (int row0 = row_lo + (wi * (NT / 64) + w) * 4; row0 < row_hi; row0 += nw * 4) {
    f32x4 v[4][4];
    const float* g = (row0 < 2 * SL) ? p.pre_g : p.mem_ng;
#pragma unroll
    for (int u = 0; u < 4; ++u) {
      const int row = row0 + u;
      const float* src;
      if (row < 2 * SL) { int s = row >> 14, r = row & (SL - 1); src = p.x[s] + (size_t)r * DM; }
      else { int r = row - 2 * SL; src = (r < 256) ? p.mem[0] + (size_t)r * DM : p.mem[1] + (size_t)(r - 256) * DM; }
#pragma unroll
      for (int i = 0; i < 4; ++i) v[u][i] = __builtin_nontemporal_load((const f32x4*)(src + (i * 64 + lane) * 4));
    }
    f32x4 gg[4];
#pragma unroll
    for (int i = 0; i < 4; ++i) gg[i] = *(const f32x4*)(g + (i * 64 + lane) * 4);
#pragma unroll
    for (int u = 0; u < 4; ++u) {
      const int row = row0 + u;
      u16* dst;
      if (row < 2 * SL) { int s = row >> 14, r = row & (SL - 1); dst = (u16*)(p.out + (size_t)s * SL * DM) + (size_t)r * DM; }
      else dst = p.hm + (size_t)(row - 2 * SL) * DM;
      float ss = 0.f;
#pragma unroll
      for (int i = 0; i < 4; ++i) ss += v[u][i][0] * v[u][i][0] + v[u][i][1] * v[u][i][1] + v[u][i][2] * v[u][i][2] + v[u][i][3] * v[u][i][3];
      ss = wave_sum(ss);
      const float rstd = rsqrtf(ss * (1.f / DM) + 1e-6f);
#pragma unroll
      for (int i = 0; i < 4; ++i) {
        u32x2 o; o[0] = pack2(v[u][i][0] * rstd * gg[i][0], v[u][i][1] * rstd * gg[i][1]);
        o[1] = pack2(v[u][i][2] * rstd * gg[i][2], v[u][i][3] * rstd * gg[i][3]);
        *(u32x2*)(dst + (i * 64 + lane) * 4) = o;
      }
    }
  }
}

template <int MODE>
DI void transpose_tile(const float* __restrict__ src, int N, int K, u16* __restrict__ dst, int n0, int k0, char* smem) {
  float* tile = (float*)smem;
  const int tid = otid();
  {
    const int nn = tid & 127, kb = tid >> 7;
    const int np = n0 + nn;
    int sc; float scale = 1.f; bool valid = true;
    if (MODE == 0) {
      if (np < 3072) { sc = np; if (np < 512) scale = 0.08838834764831845f; }
      else if (np < 6144) { sc = np + 32; if (np < C_NK) scale = 0.125f; else if (np >= C_MQ && np < C_MG) scale = 0.08838834764831845f; }
      else if (np < 6176) { sc = np - 3072; }
      else { sc = 0; valid = false; }
    } else sc = np;
    float v[16];
#pragma unroll
    for (int i = 0; i < 16; ++i) v[i] = valid ? src[(size_t)(k0 + kb + 4 * i) * N + sc] : 0.f;
#pragma unroll
    for (int i = 0; i < 16; ++i) tile[(kb + 4 * i) * 129 + nn] = v[i] * scale;
  }
  __syncthreads();
  {
    const int kk = tid & 63, nb = tid >> 6;
#pragma unroll
    for (int i = 0; i < 16; ++i) {
      int nn = nb + 8 * i;
      dst[(size_t)(n0 + nn) * K + k0 + kk] = f2bf(tile[kk * 129 + nn]);
    }
  }
  __syncthreads();
}

DI void phase0(const Params& p, char* smem) {
  for (int t = blockIdx.x; t < 49 * 16; t += gridDim.x) transpose_tile<0>(p.w_in, 6176, 1024, p.wt_in, (t % 49) * 128, (t / 49) * 64, smem);
  for (int t = blockIdx.x; t < 8 * 16; t += gridDim.x) transpose_tile<1>(p.w_kv, 1024, 1024, p.wt_kv, (t % 8) * 128, (t / 8) * 64, smem);
  prep_rows(p, 0, SL, blockIdx.x, gridDim.x);
  prep_rows(p, 2 * SL, 2 * SL + 768, blockIdx.x, gridDim.x);
}

DI void prep_wout(const Params& p, char* smem, int wi, int wc) {
  for (int t = wi; t < 8 * 32; t += wc) transpose_tile<1>(p.w_out, 1024, 2048, p.wt_out, (t % 8) * 128, (t / 8) * 64, smem);
}

template <int MODE>
DI void gemm_tile(const u16* __restrict__ A, int lda, const u16* __restrict__ Bt, int K, int m0, int n0, void* outp, char* smem) {
  u16* As0 = (u16*)smem;
  u16* Bs0 = As0 + 256 * 72;
  u16* As1 = Bs0 + 128 * 72;
  u16* Bs1 = As1 + 256 * 72;
  const int tid = otid(), lane = tid & 63, w = tid >> 6, h = lane >> 5, l31 = lane & 31;
  const int wm = w >> 1, wn = w & 1;
  const int lrow = tid >> 3, kc = tid & 7;
  f32x16 acc[2][2];
#pragma unroll
  for (int i = 0; i < 2; ++i)
#pragma unroll
    for (int j = 0; j < 2; ++j)
#pragma unroll
      for (int r = 0; r < 16; ++r) acc[i][j][r] = 0.f;
  u32x4 ra0[4], rb0[2], ra1[4], rb1[2];
  const int nk = K / 64;
  auto acol = [&](int k0) -> int {
    if (MODE == 2) return (k0 < 1024) ? (C_GG + k0) : ((k0 < 1536) ? (C_NG + k0 - 1024) : (C_MG + k0 - 1536));
    return k0;
  };
  const u16* Abase = A + (size_t)(m0 + lrow) * lda + kc * 8;
  const u16* Bbase = Bt + (size_t)(n0 + lrow) * K + kc * 8;
  auto gload = [&](int kt, u32x4* ra, u32x4* rb) {
    const int k0 = kt * 64; const int ac = acol(k0);
#pragma unroll
    for (int i = 0; i < 4; ++i) ra[i] = *(const u32x4*)(Abase + (size_t)(64 * i) * lda + ac);
#pragma unroll
    for (int i = 0; i < 2; ++i) rb[i] = *(const u32x4*)(Bbase + (size_t)(64 * i) * K + k0);
  };
  auto lstore = [&](u16* As, u16* Bs, const u32x4* ra, const u32x4* rb) {
#pragma unroll
    for (int i = 0; i < 4; ++i) *(u32x4*)(As + (lrow + 64 * i) * 72 + kc * 8) = ra[i];
#pragma unroll
    for (int i = 0; i < 2; ++i) *(u32x4*)(Bs + (lrow + 64 * i) * 72 + kc * 8) = rb[i];
  };
  auto step = [&](const u16* AsC, const u16* BsC, u16* AsN, u16* BsN, const u32x4* ra, const u32x4* rb, bool do_store) {
#pragma unroll
    for (int ks = 0; ks < 4; ++ks) {
      bf16x8 a[2], b[2];
#pragma unroll
      for (int i = 0; i < 2; ++i) a[i] = *(const bf16x8*)(AsC + (64 * wm + 32 * i + l31) * 72 + 16 * ks + 8 * h);
#pragma unroll
      for (int j = 0; j < 2; ++j) b[j] = *(const bf16x8*)(BsC + (64 * wn + 32 * j + l31) * 72 + 16 * ks + 8 * h);
#pragma unroll
      for (int i = 0; i < 2; ++i)
#pragma unroll
        for (int j = 0; j < 2; ++j) acc[i][j] = MFMA32(a[i], b[j], acc[i][j]);
      if (do_store) {
        if (ks == 0) { *(u32x4*)(AsN + (lrow) * 72 + kc * 8) = ra[0]; *(u32x4*)(AsN + (lrow + 64) * 72 + kc * 8) = ra[1]; }
        if (ks == 1) { *(u32x4*)(AsN + (lrow + 128) * 72 + kc * 8) = ra[2]; *(u32x4*)(AsN + (lrow + 192) * 72 + kc * 8) = ra[3]; }
        if (ks == 2) { *(u32x4*)(BsN + (lrow) * 72 + kc * 8) = rb[0]; *(u32x4*)(BsN + (lrow + 64) * 72 + kc * 8) = rb[1]; }
      }
    }
  };
  gload(0, ra0, rb0); gload(1, ra1, rb1);
  lstore(As0, Bs0, ra0, rb0);
  gload(2, ra0, rb0);
  __syncthreads();
  for (int kt = 0; kt < nk; kt += 2) {
    step(As0, Bs0, As1, Bs1, ra1, rb1, true);
    if (kt + 3 < nk) gload(kt + 3, ra1, rb1);
    __syncthreads();
    step(As1, Bs1, As0, Bs0, ra0, rb0, kt + 2 < nk);
    if (kt + 4 < nk) gload(kt + 4, ra0, rb0);
    __syncthreads();
  }
#pragma unroll
  for (int i = 0; i < 2; ++i)
#pragma unroll
    for (int j = 0; j < 2; ++j)
#pragma unroll
      for (int r = 0; r < 16; ++r) {
        const int row = m0 + 64 * wm + 32 * i + crow(r, h);
        const int col = n0 + 64 * wn + 32 * j + l31;
        if (MODE == 0) ((u16*)outp)[(size_t)row * LDP + col] = f2bf(acc[i][j][r]);
        else if (MODE == 1) ((u16*)outp)[(size_t)row * 1024 + col] = f2bf(acc[i][j][r]);
        else ((float*)outp)[(size_t)row * 1024 + col] = acc[i][j][r];
      }
}

template <int MODE>
DI void gemm_tile_big(const u16* __restrict__ A, int lda, const u16* __restrict__ Bt, int K, int m0, int n0, void* outp, char* smem) {
  u16* As0 = (u16*)smem;
  u16* Bs0 = As0 + 256 * 72;
  u16* As1 = Bs0 + 256 * 72;
  u16* Bs1 = As1 + 256 * 72;
  const int tid = otid(), lane = tid & 63, w = tid >> 6, h = lane >> 5, l31 = lane & 31;
  const int wm = w >> 2, wn = w & 3;
  const int lrow = tid >> 3, kc = tid & 7;
  f32x16 acc[4][2];
#pragma unroll
  for (int i = 0; i < 4; ++i)
#pragma unroll
    for (int j = 0; j < 2; ++j)
#pragma unroll
      for (int r = 0; r < 16; ++r) acc[i][j][r] = 0.f;
  u32x4 ra[4], rb[4];
  const int nk = K / 64;
  auto acol = [&](int k0) -> int {
    if (MODE == 2) return (k0 < 1024) ? (C_GG + k0) : ((k0 < 1536) ? (C_NG + k0 - 1024) : (C_MG + k0 - 1536));
    return k0;
  };
  const u16* Abase = A + (size_t)(m0 + lrow) * lda + kc * 8;
  const u16* Bbase = Bt + (size_t)(n0 + lrow) * K + kc * 8;
  auto gload = [&](int kt) {
    const int k0 = kt * 64; const int ac = acol(k0);
#pragma unroll
    for (int i = 0; i < 4; ++i) ra[i] = *(const u32x4*)(Abase + (size_t)(64 * i) * lda + ac);
#pragma unroll
    for (int i = 0; i < 4; ++i) rb[i] = *(const u32x4*)(Bbase + (size_t)(64 * i) * K + k0);
  };
  auto step = [&](const u16* AsC, const u16* BsC, u16* AsN, u16* BsN, bool do_store) {
#pragma unroll
    for (int ks = 0; ks < 4; ++ks) {
      bf16x8 a[4], b[2];
#pragma unroll
      for (int i = 0; i < 4; ++i) a[i] = *(const bf16x8*)(AsC + (128 * wm + 32 * i + l31) * 72 + 16 * ks + 8 * h);
#pragma unroll
      for (int j = 0; j < 2; ++j) b[j] = *(const bf16x8*)(BsC + (64 * wn + 32 * j + l31) * 72 + 16 * ks + 8 * h);
#pragma unroll
      for (int i = 0; i < 4; ++i)
#pragma unroll
        for (int j = 0; j < 2; ++j) acc[i][j] = MFMA32(a[i], b[j], acc[i][j]);
      if (do_store && ks == 2) {
#pragma unroll
        for (int i = 0; i < 4; ++i) *(u32x4*)(AsN + (lrow + 64 * i) * 72 + kc * 8) = ra[i];
      }
      if (do_store && ks == 3) {
#pragma unroll
        for (int i = 0; i < 4; ++i) *(u32x4*)(BsN + (lrow + 64 * i) * 72 + kc * 8) = rb[i];
      }
    }
  };
  gload(0);
#pragma unroll
  for (int i = 0; i < 4; ++i) { *(u32x4*)(As0 + (lrow + 64 * i) * 72 + kc * 8) = ra[i]; *(u32x4*)(Bs0 + (lrow + 64 * i) * 72 + kc * 8) = rb[i]; }
  gload(1);
  __syncthreads();
  for (int kt = 0; kt < nk; kt += 2) {
    step(As0, Bs0, As1, Bs1, true);
    if (kt + 2 < nk) gload(kt + 2);
    __syncthreads();
    step(As1, Bs1, As0, Bs0, kt + 2 < nk);
    if (kt + 3 < nk) gload(kt + 3);
    __syncthreads();
  }
#pragma unroll
  for (int i = 0; i < 4; ++i)
#pragma unroll
    for (int j = 0; j < 2; ++j)
#pragma unroll
      for (int r = 0; r < 16; ++r) {
        const int row = m0 + 128 * wm + 32 * i + crow(r, h);
        const int col = n0 + 64 * wn + 32 * j + l31;
        if (MODE == 0) ((u16*)outp)[(size_t)row * LDP + col] = f2bf(acc[i][j][r]);
        else ((u16*)outp)[(size_t)row * 2048 + col] = f2bf(acc[i][j][r]);
      }
}

template <bool PASS_C>
DI void gla_item(const Params& p, int slice, int item, char* smem, bool dry = false) {
  u16* Qs = (u16*)smem;
  u16* Ks = Qs + 64 * 136;
  u16* KTs = Ks + 64 * 136;
  u16* VTs = KTs + 128 * 72;
  float* LRs = (float*)(VTs + 256 * 72);
  float* TOT = LRs + 64 * 16;
  float* EB = TOT + 4 * 128;
  float* BL = EB + 128;
  float* WS = BL + 64 * 128;
  const int tid = otid(), lane = tid & 63, w = tid >> 6, h = lane >> 5, l31 = lane & 31;
  const int dir = item & 1, hh = (item >> 1) & 3, sg = item >> 3;
  const int d = tid & 127, tg = tid >> 7;
  const u16* proj = p.proj;
  const float* gw = dir ? p.gw_b : p.gw_f;
  const float* gb = dir ? p.gb_b : p.gb_f;
  u16* WTb = (u16*)WS;
  u16* LRb = (u16*)LRs;
#pragma unroll
  for (int i = 0; i < 4; ++i) { const int e = tid + 512 * i; const int dd = e >> 4, r = e & 15; WTb[e] = f2bf(gw[r * 512 + hh * 128 + dd]); }
  const float bias_z = gb[hh * 128 + 32 * (w >> 1) + l31];
  f32x16 S[4];
  float* Uit = p.U + (size_t)item * 32768;
#pragma unroll
  for (int dt = 0; dt < 4; ++dt)
#pragma unroll
    for (int r = 0; r < 16; ++r) S[dt][r] = PASS_C ? Uit[(dt * 16 + r) * 512 + tid] : 0.f;
  float dlog = 0.f;
  u16* odir = (u16*)(p.out + (size_t)slice * SL * DM) + (size_t)dir * SL * DM;
  const int lrcol = dir ? C_LRB : C_LRF;

  u32x4 pq[2], pk[2], pv[4], plr;
  auto gl_chunk = [&](int cc, int tid) {
    const int c = dir ? 7 - cc : cc;
    const int r0 = sg * 512 + c * 64;
#pragma unroll
    for (int i = 0; i < 2; ++i) {
      const int idx = tid + 512 * i; const int t = idx >> 4, c8 = idx & 15;
      pk[i] = *(const u32x4*)(proj + (size_t)(r0 + t) * LDP + C_GK + hh * 128 + c8 * 8);
      if (PASS_C) pq[i] = *(const u32x4*)(proj + (size_t)(r0 + t) * LDP + C_GQ + hh * 128 + c8 * 8);
    }
    if (tid < 128) plr = *(const u32x4*)(proj + (size_t)(r0 + (tid >> 1)) * LDP + lrcol + (tid & 1) * 8);
  };
  auto gl_chunk_v = [&](int cc, int tid) {
    const int c = dir ? 7 - cc : cc;
    const int r0 = sg * 512 + c * 64;
#pragma unroll
    for (int i = 0; i < 4; ++i) {
      const int idx = tid + 512 * i; const int t = idx >> 5, vg = idx & 31;
      pv[i] = *(const u32x4*)(proj + (size_t)(r0 + t) * LDP + C_GV + hh * 256 + vg * 8);
    }
  };
  gl_chunk(0, tid); gl_chunk_v(0, tid);
  const int tid_outer = tid;
  for (int cc = 0; cc < 8; ++cc) {
    int tid = tid_outer; asm volatile("" : "+v"(tid));
    const int lane = tid & 63, w = tid >> 6, h = lane >> 5, l31 = lane & 31, d = tid & 127, tg = tid >> 7;
    const int c = dir ? 7 - cc : cc;
    int row0 = sg * 512 + c * 64;
    asm volatile("" : "+s"(row0));
#pragma unroll
    for (int i = 0; i < 2; ++i) {
      const int idx = tid + 512 * i; const int t = idx >> 4, c8 = idx & 15;
      *(u32x4*)(Ks + t * 136 + c8 * 8) = pk[i];
      if (PASS_C) *(u32x4*)(Qs + t * 136 + c8 * 8) = pq[i];
    }
#pragma unroll
    for (int i = 0; i < 4; ++i) {
      const int idx = tid + 512 * i; const int t = idx >> 5, vg = idx & 31;
      *(u32x4*)(VTs + t * 288 + vg * 8) = pv[i];
    }
    if (tid < 128) *(u32x4*)(LRb + (tid >> 1) * 16 + (tid & 1) * 8) = plr;
    __syncthreads();
    if (cc + 1 < 8) { gl_chunk(cc + 1, tid); if (!PASS_C) gl_chunk_v(cc + 1, tid); }
    {
      const int ttz = w & 1, dz = 32 * (w >> 1) + l31;
      const bf16x8 az = *(const bf16x8*)(LRb + (32 * ttz + l31) * 16 + 8 * h);
      const bf16x8 bz = *(const bf16x8*)(WTb + dz * 16 + 8 * h);
      f32x16 z;
#pragma unroll
      for (int r = 0; r < 16; ++r) z[r] = 0.f;
      z = MFMA32(az, bz, z);
      float la[16];
#pragma unroll
      for (int r = 0; r < 16; ++r) la[r] = z[r] + bias_z;
      float ex[16];
#pragma unroll
      for (int r = 0; r < 16; ++r) ex[r] = __builtin_amdgcn_exp2f(-fabsf(la[r]) * 1.4426950408889634f);
#pragma unroll
      for (int r = 0; r < 16; ++r) ex[r] = __builtin_amdgcn_logf(1.f + ex[r]);
#pragma unroll
      for (int r = 0; r < 16; ++r) la[r] = (fminf(la[r], 0.f) - 0.6931471805599453f * ex[r]) * (1.f / 16.f);
      float G[4];
#pragma unroll
      for (int g = 0; g < 4; ++g) {
        if (dir) { la[4*g+2] += la[4*g+3]; la[4*g+1] += la[4*g+2]; la[4*g] += la[4*g+1]; G[g] = la[4*g]; }
        else     { la[4*g+1] += la[4*g];   la[4*g+2] += la[4*g+1]; la[4*g+3] += la[4*g+2]; G[g] = la[4*g+3]; }
      }
      float Go[4];
#pragma unroll
      for (int g = 0; g < 4; ++g) Go[g] = __shfl_xor(G[g], 32, 64);
      float base[4]; float runp = 0.f;
      if (dir) {
#pragma unroll
        for (int g = 3; g >= 0; --g) { base[g] = runp + (h == 0 ? Go[g] : 0.f); runp += G[g] + Go[g]; }
      } else {
#pragma unroll
        for (int g = 0; g < 4; ++g) { base[g] = runp + (h == 1 ? Go[g] : 0.f); runp += G[g] + Go[g]; }
      }
#pragma unroll
      for (int g = 0; g < 4; ++g)
#pragma unroll
        for (int r4 = 0; r4 < 4; ++r4) BL[(32 * ttz + 8 * g + 4 * h + r4) * 128 + dz] = la[4 * g + r4] + base[g];
      if (h == 0) TOT[ttz * 128 + dz] = runp;
    }
    __syncthreads();
    const float tot0 = TOT[d], tot1 = TOT[128 + d];
    const float all = tot0 + tot1;
    const float pre = dir ? ((tg < 2) ? tot1 : 0.f) : ((tg >= 2) ? tot0 : 0.f);
    {
      float bb[16], kv[16], qv[16];
#pragma unroll
      for (int u = 0; u < 16; ++u) {
        const int t = 16 * tg + u;
        bb[u] = BL[t * 128 + d] + pre;
        kv[u] = bf2f(Ks[t * 136 + d]);
        if (PASS_C) qv[u] = bf2f(Qs[t * 136 + d]);
      }
      float eb[16];
#pragma unroll
      for (int u = 0; u < 16; ++u) eb[u] = __builtin_amdgcn_exp2f(bb[u] * 1.4426950408889634f);
      unsigned kp[8];
#pragma unroll
      for (int i2 = 0; i2 < 8; ++i2) {
        kp[i2] = pack2(kv[2 * i2] * __builtin_amdgcn_rcpf(eb[2 * i2]), kv[2 * i2 + 1] * __builtin_amdgcn_rcpf(eb[2 * i2 + 1]));
        if (PASS_C) {
          const unsigned qp = pack2(qv[2 * i2] * eb[2 * i2], qv[2 * i2 + 1] * eb[2 * i2 + 1]);
          Ks[(16 * tg + 2 * i2) * 136 + d] = (u16)(kp[i2] & 0xffffu);
          Ks[(16 * tg + 2 * i2 + 1) * 136 + d] = (u16)(kp[i2] >> 16);
          Qs[(16 * tg + 2 * i2) * 136 + d] = (u16)(qp & 0xffffu);
          Qs[(16 * tg + 2 * i2 + 1) * 136 + d] = (u16)(qp >> 16);
        }
      }
      u32x4 k0, k1;
      k0[0] = kp[0]; k0[1] = kp[1]; k0[2] = kp[2]; k0[3] = kp[3];
      k1[0] = kp[4]; k1[1] = kp[5]; k1[2] = kp[6]; k1[3] = kp[7];
      *(u32x4*)(KTs + d * 72 + 16 * tg) = k0;
      *(u32x4*)(KTs + d * 72 + 16 * tg + 8) = k1;
    }
    if (tg == 0) { EB[d] = __expf(all); dlog += all; }
    __syncthreads();

    if (PASS_C) {
      f32x16 X00, X11, Xoff;
#pragma unroll
      for (int r = 0; r < 16; ++r) { X00[r] = 0.f; X11[r] = 0.f; Xoff[r] = 0.f; }
#pragma unroll 2
      for (int s = 0; s < 8; ++s) {
        bf16x8 a0 = *(const bf16x8*)(Ks + l31 * 136 + 16 * s + 8 * h);
        bf16x8 a1 = *(const bf16x8*)(Ks + (32 + l31) * 136 + 16 * s + 8 * h);
        bf16x8 b0 = *(const bf16x8*)(Qs + l31 * 136 + 16 * s + 8 * h);
        bf16x8 b1 = *(const bf16x8*)(Qs + (32 + l31) * 136 + 16 * s + 8 * h);
        X00 = MFMA32(a0, b0, X00);
        X11 = MFMA32(a1, b1, X11);
        bf16x8 ao = dir ? a1 : a0, bo = dir ? b0 : b1;
        Xoff = MFMA32(ao, bo, Xoff);
      }
      {
        int lo = l31 - 4 * h;
        asm volatile("" : "+v"(lo));
#pragma unroll
        for (int r = 0; r < 16; ++r) {
          const int j = (r & 3) + 8 * (r >> 2);
          const bool keep = dir ? (j >= lo) : (j <= lo);
          X00[r] = keep ? X00[r] : 0.f; X11[r] = keep ? X11[r] : 0.f;
        }
      }
      const bf16x8 x00a = pack8<0>(X00), x00b = pack8<1>(X00), x11a = pack8<0>(X11), x11b = pack8<1>(X11),
                   xofa = pack8<0>(Xoff), xofb = pack8<1>(Xoff);
      const bf16x8 vp00 = tr_frag(VTs, 288, 32 * w, 0 + 4 * h, 8 + 4 * h, lane), vp01 = tr_frag(VTs, 288, 32 * w, 16 + 4 * h, 24 + 4 * h, lane),
                   vp10 = tr_frag(VTs, 288, 32 * w, 32 + 4 * h, 40 + 4 * h, lane), vp11 = tr_frag(VTs, 288, 32 * w, 48 + 4 * h, 56 + 4 * h, lane);
#pragma unroll
      for (int it = 0; it < 2; ++it) {
        f32x16 acc;
#pragma unroll
        for (int r = 0; r < 16; ++r) acc[r] = 0.f;
        const u16* qrow = Qs + (32 * it + l31) * 136;
#pragma unroll
        for (int dt = 0; dt < 4; ++dt) {
          acc = MFMA32(ld_perm(qrow + 32 * dt, 0, h), pack8<0>(S[dt]), acc);
          acc = MFMA32(ld_perm(qrow + 32 * dt, 1, h), pack8<1>(S[dt]), acc);
        }
        if (it == 0) {
          acc = MFMA32(x00a, vp00, acc);
          acc = MFMA32(x00b, vp01, acc);
          if (dir) {
            acc = MFMA32(xofa, vp10, acc);
            acc = MFMA32(xofb, vp11, acc);
          }
        } else {
          acc = MFMA32(x11a, vp10, acc);
          acc = MFMA32(x11b, vp11, acc);
          if (!dir) {
            acc = MFMA32(xofa, vp00, acc);
            acc = MFMA32(xofb, vp01, acc);
          }
        }
#pragma unroll
        for (int r = 0; r < 16; ++r)
          if (!dry) odir[(size_t)(row0 + 32 * it + crow(r, h)) * DM + hh * 256 + 32 * w + l31] = f2bf(acc[r]);
      }
    }
    if (PASS_C && cc + 1 < 8) gl_chunk_v(cc + 1, tid);
    bf16x8 vb[4];
#pragma unroll
    for (int ks = 0; ks < 4; ++ks) vb[ks] = tr_frag(VTs, 288, 32 * w, 16 * ks + 8 * h, 16 * ks + 8 * h + 4, lane);
#pragma unroll
    for (int dt = 0; dt < 4; ++dt) {
#pragma unroll
      for (int ks = 0; ks < 4; ++ks) {
        bf16x8 a = *(const bf16x8*)(KTs + (32 * dt + l31) * 72 + 16 * ks + 8 * h);
        S[dt] = MFMA32(a, vb[ks], S[dt]);
      }
#pragma unroll
      for (int g = 0; g < 4; ++g) {
        f32x4 e = *(const f32x4*)(EB + 32 * dt + 8 * g + 4 * h);
        S[dt][4 * g + 0] *= e[0]; S[dt][4 * g + 1] *= e[1]; S[dt][4 * g + 2] *= e[2]; S[dt][4 * g + 3] *= e[3];
      }
    }
    __syncthreads();
  }
  if (!PASS_C) {
#pragma unroll
    for (int dt = 0; dt < 4; ++dt)
#pragma unroll
      for (int r = 0; r < 16; ++r) Uit[(dt * 16 + r) * 512 + tid] = S[dt][r];
    if (tg == 0) p.Dlog[item * 128 + d] = dlog;
  }
}

DI void gla_pass_b(const Params& p, int slice) {
  const int nseq = slice == 0 ? 1 : 2, segs = slice == 0 ? 32 : 16;
  const int total = nseq * 8 * 32768;
  for (int e = blockIdx.x * NT + otid(); e < total; e += gridDim.x * NT) {
    const int elem = e & 32767, hd = (e >> 15) & 7, sq = e >> 18;
    const int dir = hd & 1;
    const int t = elem & 511, dtreg = elem >> 9;
    const int hl = (t & 63) >> 5;
    const int d = 32 * (dtreg >> 4) + crow(dtreg & 15, hl);
    float carry = 0.f;
    for (int i0 = 0; i0 < segs; i0 += 16) {
      float u[16], dl[16];
#pragma unroll
      for (int k = 0; k < 16; ++k) {
        const int sgl = dir ? segs - 1 - (i0 + k) : (i0 + k);
        const int it = (sq * segs + sgl) * 8 + hd;
        u[k] = p.U[(size_t)it * 32768 + elem];
        dl[k] = p.Dlog[it * 128 + d];
      }
#pragma unroll
      for (int k = 0; k < 16; ++k) {
        const int sgl = dir ? segs - 1 - (i0 + k) : (i0 + k);
        const int it = (sq * segs + sgl) * 8 + hd;
        p.U[(size_t)it * 32768 + elem] = carry;
        carry = __expf(dl[k]) * carry + u[k];
      }
    }
  }
}

DI void gla_combine(const Params& p, int slice) {
  const int lane = otid() & 63, w = otid() >> 6;
  const int nw = gridDim.x * (NT / 64);
  const u16* of = (const u16*)(p.out + (size_t)slice * SL * DM);
  const u16* ob = of + (size_t)SL * DM;
  const int col = (lane >> 4) * 256 + (lane & 15) * 16;
  float ng[16];
#pragma unroll
  for (int i = 0; i < 4; ++i) { f32x4 t4 = *(const f32x4*)(p.gla_ng + (lane & 15) * 16 + 4 * i); ng[4*i] = t4[0]; ng[4*i+1] = t4[1]; ng[4*i+2] = t4[2]; ng[4*i+3] = t4[3]; }
  for (int row0 = (blockIdx.x * (NT / 64) + w) * 4; row0 < SL; row0 += nw * 4) {
    bf16x8 a0[4], a1[4], b0[4], b1[4], g0[4], g1[4];
#pragma unroll
    for (int u = 0; u < 4; ++u) {
      const int row = row0 + u;
      a0[u] = *(const bf16x8*)(of + (size_t)row * DM + col); a1[u] = *(const bf16x8*)(of + (size_t)row * DM + col + 8);
      b0[u] = *(const bf16x8*)(ob + (size_t)row * DM + col); b1[u] = *(const bf16x8*)(ob + (size_t)row * DM + col + 8);
      const u16* gp = p.proj + (size_t)row * LDP + C_GG + col;
      g0[u] = *(const bf16x8*)gp; g1[u] = *(const bf16x8*)(gp + 8);
    }
#pragma unroll
    for (int u = 0; u < 4; ++u) {
      u16* gp = p.proj + (size_t)(row0 + u) * LDP + C_GG + col;
      float o[16]; float ss = 0.f;
#pragma unroll
      for (int i = 0; i < 8; ++i) {
        o[i] = bf2f((u16)a0[u][i]) + bf2f((u16)b0[u][i]); o[8 + i] = bf2f((u16)a1[u][i]) + bf2f((u16)b1[u][i]);
        ss += o[i] * o[i] + o[8 + i] * o[8 + i];
      }
#pragma unroll
      for (int m = 8; m > 0; m >>= 1) ss += __shfl_xor(ss, m, 64);
      const float rstd = rsqrtf(ss * (1.f / 256.f) + 1e-6f);
      u32x4 r0, r1;
#pragma unroll
      for (int i = 0; i < 4; ++i) {
        r0[i] = pack2(o[2*i] * rstd * ng[2*i] * silu(bf2f((u16)g0[u][2*i])), o[2*i+1] * rstd * ng[2*i+1] * silu(bf2f((u16)g0[u][2*i+1])));
        r1[i] = pack2(o[8+2*i] * rstd * ng[8+2*i] * silu(bf2f((u16)g1[u][2*i])), o[8+2*i+1] * rstd * ng[8+2*i+1] * silu(bf2f((u16)g1[u][2*i+1])));
      }
      *(u32x4*)gp = r0; *(u32x4*)(gp + 8) = r1;
    }
  }
}

DI void nat_item(const Params& p, int slice, int item, char* smem, bool dry = false) {
  const int tid = otid(), lane = tid & 63, w = tid >> 6, h = lane >> 5, l31 = lane & 31;
  u16* VT = (u16*)smem + w * (64 * 96);
  float* SC = (float*)(smem + 8 * 64 * 96 * 2) + w * 64;
  float* BIAS = (float*)(smem + 8 * 64 * 96 * 2 + 8 * 64 * 4) + w * 480;
  const int nh = item & 7, R = item >> 3;
  const int rows = slice == 0 ? 256 : 128;
  const int sq = R / rows, r = R % rows;
  const int rs = min(max(r - 4, 0), rows - 8);
  const int seq0 = sq * rows * 64;
  const int qrow0 = seq0 + r * 64;
  u16* proj = p.proj;
  for (int i = lane; i < 465; i += 64) BIAS[i] = p.rpb[nh * 465 + i];
  bf16x8 bq[2][4];
#pragma unroll
  for (int qt = 0; qt < 2; ++qt)
#pragma unroll
    for (int s = 0; s < 4; ++s) bq[qt][s] = *(const bf16x8*)(proj + (size_t)(qrow0 + 32 * qt + l31) * LDP + C_NQ + nh * 64 + 16 * s + 8 * h);
  f32x16 o[2][2];
#pragma unroll
  for (int a = 0; a < 2; ++a)
#pragma unroll
    for (int b = 0; b < 2; ++b)
#pragma unroll
      for (int rr = 0; rr < 16; ++rr) o[a][b][rr] = 0.f;
  float mrun[2] = {-1e30f, -1e30f}, lrun[2] = {0.f, 0.f};
  unsigned vmask[2];
#pragma unroll
  for (int qt = 0; qt < 2; ++qt) {
    const int cq = 32 * qt + l31;
    const int cs = min(max(cq - 8, 0), 48);
    unsigned m = 0u;
#pragma unroll
    for (int kt = 0; kt < 2; ++kt)
#pragma unroll
      for (int rr = 0; rr < 16; ++rr) {
        const int ck = 32 * kt + crow(rr, h);
        m |= ((ck >= cs) && (ck < cs + 16)) ? (1u << (kt * 16 + rr)) : 0u;
      }
    vmask[qt] = m;
  }
  bf16x8 ka[2][4]; u32x4 vc[8];
  auto ld_row = [&](int kk, bf16x8 (&kf)[2][4], u32x4 (&vr)[8]) {
    const int kr0 = seq0 + (rs + kk) * 64;
#pragma unroll
    for (int i = 0; i < 8; ++i) {
      const int idx = lane + 64 * i; const int key = idx >> 3, dg = idx & 7;
      vr[i] = *(const u32x4*)(proj + (size_t)(kr0 + key) * LDP + C_NV + nh * 64 + dg * 8);
    }
#pragma unroll
    for (int kt = 0; kt < 2; ++kt)
#pragma unroll
      for (int s = 0; s < 4; ++s) kf[kt][s] = *(const bf16x8*)(proj + (size_t)(kr0 + 32 * kt + l31) * LDP + C_NK + nh * 64 + 16 * s + 8 * h);
  };
#pragma unroll 1
  for (int kk = 0; kk < 8; ++kk) {
    ld_row(kk, ka, vc);
#pragma unroll
    for (int i = 0; i < 8; ++i) {
      const int idx = lane + 64 * i; const int key = idx >> 3, dg = idx & 7;
      *(u32x4*)(VT + key * 96 + dg * 8) = vc[i];
    }
    f32x16 acc[2][2];
#pragma unroll
    for (int a = 0; a < 2; ++a)
#pragma unroll
      for (int b = 0; b < 2; ++b)
#pragma unroll
        for (int rr = 0; rr < 16; ++rr) acc[a][b][rr] = 0.f;
#pragma unroll
    for (int s = 0; s < 4; ++s)
#pragma unroll
      for (int kt = 0; kt < 2; ++kt)
#pragma unroll
        for (int qt = 0; qt < 2; ++qt) acc[kt][qt] = MFMA32(ka[kt][s], bq[qt][s], acc[kt][qt]);
    const int drow = rs + kk - r + 7;
#pragma unroll
    for (int qt = 0; qt < 2; ++qt) {
      const int cq = 32 * qt + l31;
      const float* bp = BIAS + drow * 31 + (15 - cq + 4 * h);
      float mx = -1e30f;
#pragma unroll
      for (int kt = 0; kt < 2; ++kt)
#pragma unroll
        for (int rr = 0; rr < 16; ++rr) {
          const float sc = acc[kt][qt][rr] + bp[32 * kt + (rr & 3) + 8 * (rr >> 2)];
          acc[kt][qt][rr] = ((vmask[qt] >> (kt * 16 + rr)) & 1u) ? sc : -1e30f;
          mx = fmaxf(mx, acc[kt][qt][rr]);
        }
      mx = fmaxf(mx, __shfl_xor(mx, 32, 64));
      const float mnew = fmaxf(mrun[qt], mx);
      const float alpha = __expf(mrun[qt] - mnew);
      mrun[qt] = mnew;
      float ls = 0.f;
#pragma unroll
      for (int kt = 0; kt < 2; ++kt)
#pragma unroll
        for (int rr = 0; rr < 16; ++rr) { float e = __expf(acc[kt][qt][rr] - mnew); acc[kt][qt][rr] = e; ls += e; }
      ls += __shfl_xor(ls, 32, 64);
      lrun[qt] = lrun[qt] * alpha + ls;
#pragma unroll
      for (int dt = 0; dt < 2; ++dt)
#pragma unroll
        for (int rr = 0; rr < 16; ++rr) o[qt][dt][rr] *= alpha;
    }
    bf16x8 vf[2][4];
#pragma unroll
    for (int dt = 0; dt < 2; ++dt) {
      vf[dt][0] = tr_frag(VT, 96, 32 * dt, 0 + 4 * h, 8 + 4 * h, lane);   vf[dt][1] = tr_frag(VT, 96, 32 * dt, 16 + 4 * h, 24 + 4 * h, lane);
      vf[dt][2] = tr_frag(VT, 96, 32 * dt, 32 + 4 * h, 40 + 4 * h, lane); vf[dt][3] = tr_frag(VT, 96, 32 * dt, 48 + 4 * h, 56 + 4 * h, lane);
    }
#pragma unroll
    for (int qt = 0; qt < 2; ++qt) {
      const bf16x8 p00 = pack8<0>(acc[0][qt]), p01 = pack8<1>(acc[0][qt]), p10 = pack8<0>(acc[1][qt]), p11 = pack8<1>(acc[1][qt]);
#pragma unroll
      for (int dt = 0; dt < 2; ++dt) {
        o[qt][dt] = MFMA32(vf[dt][0], p00, o[qt][dt]);
        o[qt][dt] = MFMA32(vf[dt][1], p01, o[qt][dt]);
        o[qt][dt] = MFMA32(vf[dt][2], p10, o[qt][dt]);
        o[qt][dt] = MFMA32(vf[dt][3], p11, o[qt][dt]);
      }
    }
  }
#pragma unroll
  for (int qt = 0; qt < 2; ++qt) {
    const float inv = 1.f / lrun[qt];
    u16* rowp = proj + (size_t)(qrow0 + 32 * qt + l31) * LDP + C_NG + nh * 64;
#pragma unroll
    for (int dt = 0; dt < 2; ++dt)
#pragma unroll
      for (int g = 0; g < 4; ++g) {
        u16* gp = rowp + 32 * dt + 8 * g + 4 * h;
        const bf16x4 gt = *(const bf16x4*)gp;
        u32x2 res;
        res[0] = pack2(o[qt][dt][4 * g + 0] * inv * silu(bf2f((u16)gt[0])), o[qt][dt][4 * g + 1] * inv * silu(bf2f((u16)gt[1])));
        res[1] = pack2(o[qt][dt][4 * g + 2] * inv * silu(bf2f((u16)gt[2])), o[qt][dt][4 * g + 3] * inv * silu(bf2f((u16)gt[3])));
        if (!dry) *(u32x2*)gp = res;
      }
  }
}

DI void mem_item(const Params& p, int slice, int item, char* smem, bool dry = false) {
  const int tid = otid(), lane = tid & 63, w = tid >> 6, h = lane >> 5, l31 = lane & 31;
  u16* VT = (u16*)smem;
  u16* KM = VT + 256 * 144;
  const int mh = item & 3, tb = item >> 2;
  const int batch = slice == 0 ? 0 : (tb < 32 ? 1 : 2);
  const u16* mkv = p.mkv + (size_t)batch * 256 * 1024;
  u16* proj = p.proj;
#pragma unroll
  for (int i = 0; i < 8; ++i) {
    int idx = tid + 512 * i; int key = idx >> 4, dg = idx & 15;
    *(u32x4*)(VT + key * 144 + dg * 8) = *(const u32x4*)(mkv + (size_t)key * 1024 + 512 + mh * 128 + dg * 8);
    *(u32x4*)(KM + key * 136 + dg * 8) = *(const u32x4*)(mkv + (size_t)key * 1024 + mh * 128 + dg * 8);
  }
  const int qrow = tb * 256 + 32 * w + l31;
  bf16x8 bq[8];
#pragma unroll
  for (int s = 0; s < 8; ++s) bq[s] = *(const bf16x8*)(proj + (size_t)qrow * LDP + C_MQ + mh * 128 + 16 * s + 8 * h);
  float* LB = (float*)(smem + 256 * 144 * 2 + 256 * 136 * 2) + w * 32;
  constexpr float kDefer = 8.f;
  float m = -1e30f;
  __syncthreads();
  f32x16 o[4];
#pragma unroll
  for (int dt = 0; dt < 4; ++dt)
#pragma unroll
    for (int rr = 0; rr < 16; ++rr) o[dt][rr] = 0.f;
  float l = 0.f;
#pragma unroll 1
  for (int kt = 0; kt < 8; ++kt) {
    f32x16 acc;
#pragma unroll
    for (int rr = 0; rr < 16; ++rr) acc[rr] = 0.f;
#pragma unroll
    for (int s = 0; s < 8; ++s) {
      bf16x8 a = *(const bf16x8*)(KM + (32 * kt + l31) * 136 + 16 * s + 8 * h);
      acc = MFMA32(a, bq[s], acc);
    }
    float mx = acc[0];
#pragma unroll
    for (int rr = 1; rr < 16; ++rr) mx = fmaxf(mx, acc[rr]);
    mx = fmaxf(mx, __shfl_xor(mx, 32, 64));
    const bool need = mx > m + kDefer;
    if (__any(need)) {
      const float mnew = need ? mx : m;
      const float alpha = __expf(m - mnew);
      m = mnew; l *= alpha;
#pragma unroll
      for (int dt = 0; dt < 4; ++dt)
#pragma unroll
        for (int rr = 0; rr < 16; ++rr) o[dt][rr] *= alpha;
    }
#pragma unroll
    for (int rr = 0; rr < 16; ++rr) { float e = __expf(acc[rr] - m); acc[rr] = e; l += e; }
    const bf16x8 p0 = pack8<0>(acc), p1 = pack8<1>(acc);
#pragma unroll
    for (int dt = 0; dt < 4; ++dt) {
      o[dt] = MFMA32(tr_frag(VT, 144, 32 * dt, 32 * kt + 4 * h, 32 * kt + 8 + 4 * h, lane), p0, o[dt]);
      o[dt] = MFMA32(tr_frag(VT, 144, 32 * dt, 32 * kt + 16 + 4 * h, 32 * kt + 24 + 4 * h, lane), p1, o[dt]);
    }
  }
  l += __shfl_xor(l, 32, 64);
  {
    const float inv = 1.f / l;
    u16* rowp = proj + (size_t)(tb * 256 + 32 * w + l31) * LDP + C_MG + mh * 128;
#pragma unroll
    for (int dt = 0; dt < 4; ++dt)
#pragma unroll
      for (int g = 0; g < 4; ++g) {
        u16* gp = rowp + 32 * dt + 8 * g + 4 * h;
        const bf16x4 gt = *(const bf16x4*)gp;
        u32x2 res;
        res[0] = pack2(o[dt][4 * g + 0] * inv * silu(bf2f((u16)gt[0])), o[dt][4 * g + 1] * inv * silu(bf2f((u16)gt[1])));
        res[1] = pack2(o[dt][4 * g + 2] * inv * silu(bf2f((u16)gt[2])), o[dt][4 * g + 3] * inv * silu(bf2f((u16)gt[3])));
        if (!dry) *(u32x2*)gp = res;
      }
  }
  __syncthreads();
}

DI void final_norm(const Params& p, int slice, int wi, int wc) {
  const int lane = otid() & 63, w = otid() >> 6;
  const int nw = wc * (NT / 64);
  f32x4 g[4];
#pragma unroll
  for (int i = 0; i < 4; ++i) g[i] = *(const f32x4*)(p.post_g + (i * 64 + lane) * 4);
  for (int r0 = (wi * (NT / 64) + w) * 4; r0 < SL; r0 += nw * 4) {
    bf16x4 vb[4][4]; f32x4 xq[4][4];
#pragma unroll
    for (int u = 0; u < 4; ++u) {
      const u16* o = (const u16*)(p.out + ((size_t)slice * SL + r0 + u) * DM);
      const float* xs = p.x[slice] + (size_t)(r0 + u) * DM;
#pragma unroll
      for (int i = 0; i < 4; ++i) { vb[u][i] = __builtin_nontemporal_load((const bf16x4*)(o + (i * 64 + lane) * 4)); xq[u][i] = __builtin_nontemporal_load((const f32x4*)(xs + (i * 64 + lane) * 4)); }
    }
    float rstd[4];
#pragma unroll
    for (int u = 0; u < 4; ++u) {
      float ss = 0.f;
#pragma unroll
      for (int i = 0; i < 4; ++i)
#pragma unroll
        for (int c = 0; c < 4; ++c) { const float v = bf2f((u16)vb[u][i][c]); ss += v * v; }
      ss = wave_sum(ss);
      rstd[u] = rsqrtf(ss * (1.f / DM) + 1e-6f);
    }
#pragma unroll
    for (int u = 0; u < 4; ++u) {
      float* o = p.out + ((size_t)slice * SL + r0 + u) * DM;
#pragma unroll
      for (int i = 0; i < 4; ++i) {
        f32x4 y;
#pragma unroll
        for (int c = 0; c < 4; ++c) y[c] = xq[u][i][c] + bf2f((u16)vb[u][i][c]) * rstd[u] * g[i][c];
        __builtin_nontemporal_store(y, (f32x4*)(o + (i * 64 + lane) * 4));
      }
    }
  }
}

DI int xq(int v, int G, int& x) { const int b = v % G, i = v / G; x = b & 7; return (b >> 3) + (G >> 3) * i; }
DI void map_p1(int v, int G, int& m, int& n) {
  if (G != 256) { m = v / 49; n = v % 49; return; }
  int x; const int q = xq(v, G, x);
  if (q >= 392) { m = -1; n = 0; return; }
  const int mh = q / 196, rem = q % 196;
  n = rem >> 2; m = 8 * x + 4 * mh + (rem & 3);
}
DI void map_out(int v, int G, int& m, int& n) {
  if (G != 256) { m = v / 8; n = v % 8; return; }
  int x; const int q = xq(v, G, x);
  if (q >= 64) { m = -1; n = 0; return; }
  n = (q >> 2) & 7; m = 8 * x + 4 * (q >> 5) + (q & 3);
}
DI void map_p1_big(int v, int G, int& m, int& n) {
  if (G != 256) { m = v / 24; n = v % 24; return; }
  int x; const int q = xq(v, G, x);
  if (q >= 192) { m = -1; n = 0; return; }
  n = q >> 3; m = 8 * x + (q & 7);
}
DI void map_out_big(int v, int G, int& m, int& n) {
  if (G != 256) { m = v / 4; n = v % 4; return; }
  int x; const int q = xq(v, G, x);
  if (q >= 32) { m = -1; n = 0; return; }
  n = (q >> 2) & 3; m = 8 * x + 4 * (q >> 4) + (q & 3);
}
DI int map_gla(int v, int G) {
  if (G != 256) return v;
  int x; const int q = xq(v, G, x);
  if (q >= 32) return -1;
  return (4 * x + (q >> 3)) * 8 + (q & 7);
}
DI int map_natrow(int v, int G) {
  if (G != 256) return v;
  int x; const int q = xq(v, G, x);
  if (q >= 32) return -1;
  return 32 * x + q;
}
#define GSYNC() do { xcd_barrier(xb); if (DUP & 64) xcd_barrier(xb); } while (0)
__global__ void __launch_bounds__(NT) mega_kernel(Params p) {
  __shared__ __attribute__((aligned(16))) char smem[SMEM_BYTES];
  __shared__ uint4 xb_words;
  cg::grid_group grid = cg::this_grid();
  const int G = gridDim.x, B = blockIdx.x;
  if (threadIdx.x == 0) xb_words = make_uint4(0u, 0u, 0u, 0u);
  __syncthreads();
  const XcdBarrier xb = xcd_barrier_post(p.bar, (volatile LAS unsigned*)&xb_words);

  if (PH & 1) phase0(p, smem);
  if (DUP & 32) phase0(p, smem);
  if (p.use_cg_sync) grid.sync(); else GSYNC();
#pragma unroll 1
  for (int s = 0; s < 2; ++s) {
    {
      const u16* hA = (const u16*)(p.out + (size_t)s * SL * DM);
      if (PH & 2) {
        const int w_lo = (G == 256) ? (s == 0 ? 88 : 64) : 0;
        const int wi = B - w_lo, wc = G - w_lo;
        const int extra_at = (B >> 3) % 6; int ti = 0; bool extra_done = (wi < 0);
        for (int rp = 1; rp < p.rep_p1; ++rp)
          for (int t = B; t < 64 * 24; t += G) { int m, n; map_p1_big(t, G, m, n); if (m < 0 || m >= 64) break; gemm_tile_big<0>(hA, DM, p.wt_in, 1024, m * 256, n * 256, p.proj, smem); }
        for (int t = B; t < 64 * 24; t += G, ++ti) {
          if (ti == extra_at && !extra_done) { if (s == 0) { prep_rows(p, SL, 2 * SL, wi, wc); prep_wout(p, smem, wi, wc); } else if (PH & 8) final_norm(p, 0, wi, wc); extra_done = true; }
          int m, n; map_p1_big(t, G, m, n); if (m < 0 || m >= 64) break; gemm_tile_big<0>(hA, DM, p.wt_in, 1024, m * 256, n * 256, p.proj, smem);
        }
        if (!extra_done) { if (s == 0) { prep_rows(p, SL, 2 * SL, wi, wc); prep_wout(p, smem, wi, wc); } else if (PH & 8) final_norm(p, 0, wi, wc); }
        for (int t = B; t < 64; t += G) gemm_tile<0>(hA, DM, p.wt_in, 1024, t * 256, 6144, p.proj, smem);
      }
      if (DUP & 8) {
        for (int t = B; t < 64 * 24; t += G) { int m, n; map_p1_big(t, G, m, n); if (m < 0 || m >= 64) break; gemm_tile_big<0>(hA, DM, p.wt_in, 1024, m * 256, n * 256, p.proj, smem); }
        for (int t = B; t < 64; t += G) gemm_tile<0>(hA, DM, p.wt_in, 1024, t * 256, 6144, p.proj, smem);
      }
      if (s == 0) {
        if (PH & 4) for (int t = (B >= 64 ? B - 64 : B + G - 64); t < 3 * 8; t += G) gemm_tile<1>(p.hm, DM, p.wt_kv, 1024, (t / 8) * 256, (t % 8) * 128, p.mkv, smem);
      }
    }
    GSYNC();
    if (PH & 16) for (int t = B; t < 256; t += G) { const int it = map_gla(t, G); if (it < 0) break; gla_item<false>(p, s, it, smem); }
    if (DUP & (1 | 256)) for (int t = B; t < 256; t += G) { const int it = map_gla(t, G); if (it < 0) break; gla_item<false>(p, s, it, smem); }
    if (DUP & 2) for (int t = B; t < 256; t += G) { const int R = map_natrow(t, G); if (R < 0) break; nat_item(p, s, R * 8 + (otid() >> 6), smem, p.dry != 0); }
    if (PH & 32) { for (int t = B; t < 256; t += G) { const int R = map_natrow(t, G); if (R < 0) break; nat_item(p, s, R * 8 + (otid() >> 6), smem); } __syncthreads(); }
    if (DUP & 4) for (int t = B; t < 256; t += G) mem_item(p, s, t, smem, p.dry != 0);
    if (PH & 64) for (int t = B; t < 256; t += G) mem_item(p, s, t, smem);
    GSYNC();
    if (PH & 128) gla_pass_b(p, s);
    GSYNC();
    if (PH & 256) for (int t = B; t < 256; t += G) { const int it = map_gla(t, G); if (it < 0) break; gla_item<true>(p, s, it, smem); }
    if (DUP & (1 | 512)) for (int t = B; t < 256; t += G) { const int it = map_gla(t, G); if (it < 0) break; gla_item<true>(p, s, it, smem); }
    if (DUP & 1024) for (int t = B; t < 256; t += G) { const int it = map_gla(t, G); if (it < 0) break; gla_item<true>(p, s, it, smem, p.dry != 0); }
    GSYNC();
    if (PH & 512) gla_combine(p, s);
    GSYNC();
    {
      float* od = p.out + (size_t)s * SL * DM;
      if (PH & 1024) for (int t = B; t < 64 * 4; t += G) { int m, n; map_out_big(t, G, m, n); if (m < 0 || m >= 64) break; gemm_tile_big<2>(p.proj, LDP, p.wt_out, 2048, m * 256, n * 256, od, smem); }
      if (DUP & 16) for (int t = B; t < 64 * 4; t += G) { int m, n; map_out_big(t, G, m, n); if (m < 0 || m >= 64) break; gemm_tile_big<2>(p.proj, LDP, p.wt_out, 2048, m * 256, n * 256, od, smem); }
    }
    GSYNC();
  }
  if (PH & 8) final_norm(p, 1, B, G);
}

extern "C" void kernel_launch(void* const* d_in, const int* in_sizes, int n_in, void* d_out, int out_size, void* d_ws,
                              size_t ws_size, hipStream_t stream) {
  static int grid_blocks = 0;
  if (!grid_blocks) {
    int dev = 0, cus = 0, per_cu = 0;
    hipGetDevice(&dev);
    hipDeviceGetAttribute(&cus, hipDeviceAttributeMultiprocessorCount, dev);
    hipOccupancyMaxActiveBlocksPerMultiprocessor(&per_cu, mega_kernel, NT, 0);
    if (per_cu < 1) per_cu = 1;
    if (per_cu > 1) per_cu = 1;
    grid_blocks = cus * per_cu;
  }
  Params p{};
  p.x[0] = (const float*)d_in[0]; p.x[1] = (const float*)d_in[1];
  p.mem[0] = (const float*)d_in[2]; p.mem[1] = (const float*)d_in[3];
  p.pre_g = (const float*)d_in[4]; p.w_in = (const float*)d_in[5];
  p.gw_f = (const float*)d_in[6]; p.gb_f = (const float*)d_in[7];
  p.gw_b = (const float*)d_in[8]; p.gb_b = (const float*)d_in[9];
  p.gla_ng = (const float*)d_in[10]; p.rpb = (const float*)d_in[11];
  p.mem_ng = (const float*)d_in[12]; p.w_kv = (const float*)d_in[13];
  p.w_out = (const float*)d_in[14]; p.post_g = (const float*)d_in[15];
  p.out = (float*)d_out;
  p.dry = 1;
  p.rep_p1 = REP_P1;
  p.use_cg_sync = 0;
  char* ws = (char*)d_ws; size_t off = 0;
  auto take = [&](size_t bytes) { char* r = ws + off; off += (bytes + 255) & ~(size_t)255; return r; };
  p.proj = (u16*)take((size_t)SL * LDP * 2);
  p.U = (float*)take((size_t)256 * 32768 * 4);
  p.Dlog = (float*)take((size_t)256 * 128 * 4);
  p.wt_in = (u16*)take((size_t)LDP * 1024 * 2);
  p.wt_kv = (u16*)take((size_t)1024 * 1024 * 2);
  p.wt_out = (u16*)take((size_t)1024 * 2048 * 2);
  p.hm = (u16*)take((size_t)768 * 1024 * 2);
  p.mkv = (u16*)take((size_t)768 * 1024 * 2);
  p.bar = (unsigned*)take((size_t)XCD_BAR_WORDS * 4);
  if (off > ws_size) { fprintf(stderr, "workspace too small: need %zu have %zu\n", off, ws_size); return; }
  hipMemsetAsync(p.bar, 0, (size_t)XCD_BAR_WORDS * 4, stream);
  void* args[] = {&p};
  hipError_t e = hipLaunchCooperativeKernel((void*)mega_kernel, dim3(grid_blocks), dim3(NT), args, 0, stream);
  if (e != hipSuccess) fprintf(stderr, "cooperative launch failed: %s (grid %d)\n", hipGetErrorString(e), grid_blocks);
}
```

```cpp
#include <hip/hip_runtime.h>
#include <hip/hip_cooperative_groups.h>
#include <cstdio>
namespace cg = cooperative_groups;

typedef unsigned short u16;
typedef __attribute__((ext_vector_type(8))) short bf16x8;
typedef __attribute__((ext_vector_type(4))) short bf16x4;
typedef __attribute__((ext_vector_type(16))) float f32x16;
typedef __attribute__((ext_vector_type(4))) float f32x4;
typedef __attribute__((ext_vector_type(4))) unsigned u32x4;
typedef __attribute__((ext_vector_type(2))) unsigned u32x2;

#define DI __device__ __forceinline__
#define MFMA32(a, b, c) __builtin_amdgcn_mfma_f32_32x32x16_bf16((a), (b), (c), 0, 0, 0)

static constexpr int NT = 512;
static constexpr int SL = 16384;
static constexpr int DM = 1024;
static constexpr int LDP = 6272;
static constexpr int C_GQ = 0, C_GK = 512, C_GV = 1024, C_GG = 2048, C_NQ = 3072, C_NK = 3584, C_NV = 4096,
                     C_NG = 4608, C_MQ = 5120, C_MG = 5632, C_LRF = 6144, C_LRB = 6160;
static constexpr int SMEM_BYTES = 144 * 1024;
#ifndef PH
#define PH 0xFFF
#endif
#ifndef DUP
#define DUP 0
#endif
#ifndef REP_P1
#define REP_P1 1
#endif

struct Params {
  const float* x[2];
  const float* mem[2];
  const float *pre_g, *w_in, *gw_f, *gb_f, *gw_b, *gb_b, *gla_ng, *rpb, *mem_ng, *w_kv, *w_out, *post_g;
  float* out;
  u16 *proj, *wt_in, *wt_kv, *wt_out, *hm, *mkv;
  float *U, *Dlog;
  unsigned* bar;
  int dry; int rep_p1; int use_cg_sync; int pad3_;
};

typedef __attribute__((ext_vector_type(2))) __bf16 bf16v2;
typedef __attribute__((ext_vector_type(2))) float f32x2;
DI unsigned pack2(float a, float b) { f32x2 v; v[0] = a; v[1] = b; return __builtin_bit_cast(unsigned, __builtin_convertvector(v, bf16v2)); }
DI u16 f2bf(float x) { return (u16)(pack2(x, 0.f) & 0xffffu); }
DI float bf2f(u16 v) { return __uint_as_float(((unsigned)v) << 16); }
DI int otid() { int t = (int)threadIdx.x; asm volatile("" : "+v"(t)); return t; }
DI int crow(int reg, int h) { return (reg & 3) + 8 * (reg >> 2) + 4 * h; }
DI float silu(float g) { return g * __builtin_amdgcn_rcpf(1.f + __expf(-g)); }
DI float wave_sum(float v) {
#pragma unroll
  for (int o = 32; o > 0; o >>= 1) v += __shfl_xor(v, o, 64);
  return v;
}
template <int S> DI bf16x8 pack8(const f32x16& x) {
  u32x4 p;
  p[0] = pack2(x[8 * S + 0], x[8 * S + 1]); p[1] = pack2(x[8 * S + 2], x[8 * S + 3]);
  p[2] = pack2(x[8 * S + 4], x[8 * S + 5]); p[3] = pack2(x[8 * S + 6], x[8 * S + 7]);
  return __builtin_bit_cast(bf16x8, p);
}
DI bf16x8 ld_perm(const u16* rowbase, int s, int h) {
  bf16x4 lo = *(const bf16x4*)(rowbase + 16 * s + 4 * h);
  bf16x4 hi = *(const bf16x4*)(rowbase + 16 * s + 8 + 4 * h);
  return __builtin_shufflevector(lo, hi, 0, 1, 2, 3, 4, 5, 6, 7);
}


DI bf16x8 gather_nat(const u16* colp, int ld, int k0) {
  u32x4 r;
#pragma unroll
  for (int j = 0; j < 4; ++j) r[j] = (unsigned)colp[(k0 + 2 * j) * ld] | ((unsigned)colp[(k0 + 2 * j + 1) * ld] << 16);
  return __builtin_bit_cast(bf16x8, r);
}
DI bf16x8 gather_perm(const u16* colp, int ld, int kb, int s, int h) {
  const int k0 = kb + 16 * s + 4 * h;
  u32x4 r;
  r[0] = (unsigned)colp[(k0 + 0) * ld] | ((unsigned)colp[(k0 + 1) * ld] << 16);
  r[1] = (unsigned)colp[(k0 + 2) * ld] | ((unsigned)colp[(k0 + 3) * ld] << 16);
  r[2] = (unsigned)colp[(k0 + 8) * ld] | ((unsigned)colp[(k0 + 9) * ld] << 16);
  r[3] = (unsigned)colp[(k0 + 10) * ld] | ((unsigned)colp[(k0 + 11) * ld] << 16);
  return __builtin_bit_cast(bf16x8, r);
}

typedef __attribute__((ext_vector_type(4))) short s16x4;
#define LDS3 __attribute__((address_space(3)))
DI bf16x8 tr_frag(const u16* tile, int ld, int col0, int r0, int r1, int lane) {
  const int q = (lane & 15) >> 2, pcol = col0 + 16 * ((lane >> 4) & 1) + 4 * (lane & 3);
  const s16x4 lo = __builtin_amdgcn_ds_read_tr16_b64_v4i16((LDS3 s16x4*)(tile + (r0 + q) * ld + pcol));
  const s16x4 hi = __builtin_amdgcn_ds_read_tr16_b64_v4i16((LDS3 s16x4*)(tile + (r1 + q) * ld + pcol));
  return __builtin_shufflevector(lo, hi, 0, 1, 2, 3, 4, 5, 6, 7);
}

#define XB_TMO      128
#define XB_XCNT(j)  (256  + 64 * (j))
#define XB_XSUB(j)  (1280 + 64 * (j))
#define XB_XGEN(j)  (2304 + 64 * (j))
#define XB_TOP      3328
#define XB_TOPGEN   3392
#define XCD_BAR_WORDS 3456
#define XB_SPIN_CAP (1u << 18)
#define LAS __attribute__((address_space(3)))
DI unsigned xb_ld(unsigned* p)              { return __hip_atomic_load(p, __ATOMIC_RELAXED, __HIP_MEMORY_SCOPE_AGENT); }
DI unsigned xb_add(unsigned* p, unsigned v) { return __hip_atomic_fetch_add(p, v, __ATOMIC_RELAXED, __HIP_MEMORY_SCOPE_AGENT); }
DI unsigned xb_xcc_id() { return (unsigned)__builtin_amdgcn_s_getreg((3 << 11) | 20) & 0xFu; }
#define XB_SPIN(cond, bar) do { unsigned _sp = 0; while (cond) { __builtin_amdgcn_s_sleep(1); \
    if ((++_sp & 255u) == 0u) { if (xb_ld(&(bar)[XB_TMO])) break; if (_sp > XB_SPIN_CAP) { atomicAdd(&(bar)[XB_TMO], 1u); break; } } } } while (0)
struct XcdBarrier { unsigned* bar; unsigned x; volatile LAS unsigned* st; };
DI XcdBarrier xcd_barrier_post(unsigned* bar, volatile LAS unsigned* st) {
  XcdBarrier b; b.bar = bar; b.x = xb_xcc_id(); b.st = st;
  if (threadIdx.x == 0) (void)xb_add(&bar[XB_XCNT(b.x)], 1u);
  return b;
}
DI void xcd_barrier_complete(unsigned* bar, unsigned x, unsigned& nloc, unsigned& nx) {
  const unsigned G = gridDim.x * gridDim.y * gridDim.z;
  unsigned sum, cnt, mine, sp = 0u;
  for (;;) {
    sum = 0u; cnt = 0u; mine = 0u;
#pragma unroll
    for (unsigned j = 0; j < 16; ++j) { const unsigned c = xb_ld(&bar[XB_XCNT(j)]); sum += c; cnt += (c > 0u) ? 1u : 0u; mine = (j == x) ? c : mine; }
    if (sum == G) break;
    __builtin_amdgcn_s_sleep(1);
    if ((++sp & 255u) == 0u) { if (xb_ld(&bar[XB_TMO])) break; if (sp > XB_SPIN_CAP) { atomicAdd(&bar[XB_TMO], 1u); break; } }
  }
  nloc = mine > 0u ? mine : 1u; nx = cnt > 0u ? cnt : 1u;
}
DI void xcd_barrier(const XcdBarrier& b) {
  asm volatile("s_waitcnt vmcnt(0)" ::: "memory");
  __syncthreads();
  if (threadIdx.x == 0) {
    unsigned* bar = b.bar;
    __builtin_amdgcn_s_waitcnt(0);
    unsigned nloc = b.st[0], nx = b.st[1];
    if (nloc == 0u) { xcd_barrier_complete(bar, b.x, nloc, nx); b.st[0] = nloc; b.st[1] = nx; }
    const unsigned old = xb_add(&bar[XB_XSUB(b.x)], 1u);
    const unsigned gen = old / nloc;
    if (old + 1u == (gen + 1u) * nloc) {
      __builtin_amdgcn_fence(__ATOMIC_RELEASE, "agent");
      asm volatile("s_waitcnt vmcnt(0)" ::: "memory");
      const unsigned og = xb_add(&bar[XB_TOP], 1u);
      const unsigned tg = og / nx;
      if (og + 1u == (tg + 1u) * nx) xb_add(&bar[XB_TOPGEN], 1u);
      else XB_SPIN(xb_ld(&bar[XB_TOPGEN]) == tg, bar);
      __builtin_amdgcn_fence(__ATOMIC_ACQUIRE, "agent");
      xb_add(&bar[XB_XGEN(b.x)], 1u);
      asm volatile("s_waitcnt vmcnt(0)" ::: "memory");
    } else {
      XB_SPIN(xb_ld(&bar[XB_XGEN(b.x)]) == gen, bar);
      __builtin_amdgcn_fence(__ATOMIC_ACQUIRE, "agent");
      asm volatile("s_waitcnt vmcnt(0)" ::: "memory");
    }
  }
  __syncthreads();
}

DI void prep_rows(const Params& p, int row_lo, int row_hi, int wi, int wc) {
  const int lane = otid() & 63, w = otid() >> 6;
  const int nw = wc * (NT / 64);
  for (int row0 = row_lo + (wi * (NT / 64) + w) * 4; row0 < row_hi; row0 += nw * 4) {
    f32x4 v[4][4];
    const float* g = (row0 < 2 * SL) ? p.pre_g : p.mem_ng;
#pragma unroll
    for (int u = 0; u < 4; ++u) {
      const int row = row0 + u;
      const float* src;
      if (row < 2 * SL) { int s = row >> 14, r = row & (SL - 1); src = p.x[s] + (size_t)r * DM; }
      else { int r = row - 2 * SL; src = (r < 256) ? p.mem[0] + (size_t)r * DM : p.mem[1] + (size_t)(r - 256) * DM; }
#pragma unroll
      for (int i = 0; i < 4; ++i) v[u][i] = __builtin_nontemporal_load((const f32x4*)(src + (i * 64 + lane) * 4));
    }
    f32x4 gg[4];
#pragma unroll
    for (int i = 0; i < 4; ++i) gg[i] = *(const f32x4*)(g + (i * 64 + lane) * 4);
#pragma unroll
    for (int u = 0; u < 4; ++u) {
      const int row = row0 + u;
      u16* dst;
      if (row < 2 * SL) { int s = row >> 14, r = row & (SL - 1); dst = (u16*)(p.out + (size_t)s * SL * DM) + (size_t)r * DM; }
      else dst = p.hm + (size_t)(row - 2 * SL) * DM;
      float ss = 0.f;
#pragma unroll
      for (int i = 0; i < 4; ++i) ss += v[u][i][0] * v[u][i][0] + v[u][i][1] * v[u][i][1] + v[u][i][2] * v[u][i][2] + v[u][i][3] * v[u][i][3];
      ss = wave_sum(ss);
      const float rstd = rsqrtf(ss * (1.f / DM) + 1e-6f);
#pragma unroll
      for (int i = 0; i < 4; ++i) {
        u32x2 o; o[0] = pack2(v[u][i][0] * rstd * gg[i][0], v[u][i][1] * rstd * gg[i][1]);
        o[1] = pack2(v[u][i][2] * rstd * gg[i][2], v[u][i][3] * rstd * gg[i][3]);
        *(u32x2*)(dst + (i * 64 + lane) * 4) = o;
      }
    }
  }
}

template <int MODE>
DI void transpose_tile(const float* __restrict__ src, int N, int K, u16* __restrict__ dst, int n0, int k0, char* smem) {
  float* tile = (float*)smem;
  const int tid = otid();
  {
    const int nn = tid & 127, kb = tid >> 7;
    const int np = n0 + nn;
    int sc; float scale = 1.f; bool valid = true;
    if (MODE == 0) {
      if (np < 3072) { sc = np; if (np < 512) scale = 0.08838834764831845f; }
      else if (np < 6144) { sc = np + 32; if (np < C_NK) scale = 0.125f; else if (np >= C_MQ && np < C_MG) scale = 0.08838834764831845f; }
      else if (np < 6176) { sc = np - 3072; }
      else { sc = 0; valid = false; }
    } else sc = np;
    float v[16];
#pragma unroll
    for (int i = 0; i < 16; ++i) v[i] = valid ? src[(size_t)(k0 + kb + 4 * i) * N + sc] : 0.f;
#pragma unroll
    for (int i = 0; i < 16; ++i) tile[(kb + 4 * i) * 129 + nn] = v[i] * scale;
  }
  __syncthreads();
  {
    const int kk = tid & 63, nb = tid >> 6;
#pragma unroll
    for (int i = 0; i < 16; ++i) {
      int nn = nb + 8 * i;
      dst[(size_t)(n0 + nn) * K + k0 + kk] = f2bf(tile[kk * 129 + nn]);
    }
  }
  __syncthreads();
}

DI void phase0(const Params& p, char* smem) {
  for (int t = blockIdx.x; t < 49 * 16; t += gridDim.x) transpose_tile<0>(p.w_in, 6176, 1024, p.wt_in, (t % 49) * 128, (t / 49) * 64, smem);
  for (int t = blockIdx.x; t < 8 * 16; t += gridDim.x) transpose_tile<1>(p.w_kv, 1024, 1024, p.wt_kv, (t % 8) * 128, (t / 8) * 64, smem);
  prep_rows(p, 0, SL, blockIdx.x, gridDim.x);
  prep_rows(p, 2 * SL, 2 * SL + 768, blockIdx.x, gridDim.x);
}

DI void prep_wout(const Params& p, char* smem, int wi, int wc) {
  for (int t = wi; t < 8 * 32; t += wc) transpose_tile<1>(p.w_out, 1024, 2048, p.wt_out, (t % 8) * 128, (t / 8) * 64, smem);
}

template <int MODE>
DI void gemm_tile(const u16* __restrict__ A, int lda, const u16* __restrict__ Bt, int K, int m0, int n0, void* outp, char* smem) {
  u16* As0 = (u16*)smem;
  u16* Bs0 = As0 + 256 * 72;
  u16* As1 = Bs0 + 128 * 72;
  u16* Bs1 = As1 + 256 * 72;
  const int tid = otid(), lane = tid & 63, w = tid >> 6, h = lane >> 5, l31 = lane & 31;
  const int wm = w >> 1, wn = w & 1;
  const int lrow = tid >> 3, kc = tid & 7;
  f32x16 acc[2][2];
#pragma unroll
  for (int i = 0; i < 2; ++i)
#pragma unroll
    for (int j = 0; j < 2; ++j)
#pragma unroll
      for (int r = 0; r < 16; ++r) acc[i][j][r] = 0.f;
  u32x4 ra0[4], rb0[2], ra1[4], rb1[2];
  const int nk = K / 64;
  auto acol = [&](int k0) -> int {
    if (MODE == 2) return (k0 < 1024) ? (C_GG + k0) : ((k0 < 1536) ? (C_NG + k0 - 1024) : (C_MG + k0 - 1536));
    return k0;
  };
  const u16* Abase = A + (size_t)(m0 + lrow) * lda + kc * 8;
  const u16* Bbase = Bt + (size_t)(n0 + lrow) * K + kc * 8;
  auto gload = [&](int kt, u32x4* ra, u32x4* rb) {
    const int k0 = kt * 64; const int ac = acol(k0);
#pragma unroll
    for (int i = 0; i < 4; ++i) ra[i] = *(const u32x4*)(Abase + (size_t)(64 * i) * lda + ac);
#pragma unroll
    for (int i = 0; i < 2; ++i) rb[i] = *(const u32x4*)(Bbase + (size_t)(64 * i) * K + k0);
  };
  auto lstore = [&](u16* As, u16* Bs, const u32x4* ra, const u32x4* rb) {
#pragma unroll
    for (int i = 0; i < 4; ++i) *(u32x4*)(As + (lrow + 64 * i) * 72 + kc * 8) = ra[i];
#pragma unroll
    for (int i = 0; i < 2; ++i) *(u32x4*)(Bs + (lrow + 64 * i) * 72 + kc * 8) = rb[i];
  };
  auto step = [&](const u16* AsC, const u16* BsC, u16* AsN, u16* BsN, const u32x4* ra, const u32x4* rb, bool do_store) {
#pragma unroll
    for (int ks = 0; ks < 4; ++ks) {
      bf16x8 a[2], b[2];
#pragma unroll
      for (int i = 0; i < 2; ++i) a[i] = *(const bf16x8*)(AsC + (64 * wm + 32 * i + l31) * 72 + 16 * ks + 8 * h);
#pragma unroll
      for (int j = 0; j < 2; ++j) b[j] = *(const bf16x8*)(BsC + (64 * wn + 32 * j + l31) * 72 + 16 * ks + 8 * h);
#pragma unroll
      for (int i = 0; i < 2; ++i)
#pragma unroll
        for (int j = 0; j < 2; ++j) acc[i][j] = MFMA32(a[i], b[j], acc[i][j]);
      if (do_store) {
        if (ks == 0) { *(u32x4*)(AsN + (lrow) * 72 + kc * 8) = ra[0]; *(u32x4*)(AsN + (lrow + 64) * 72 + kc * 8) = ra[1]; }
        if (ks == 1) { *(u32x4*)(AsN + (lrow + 128) * 72 + kc * 8) = ra[2]; *(u32x4*)(AsN + (lrow + 192) * 72 + kc * 8) = ra[3]; }
        if (ks == 2) { *(u32x4*)(BsN + (lrow) * 72 + kc * 8) = rb[0]; *(u32x4*)(BsN + (lrow + 64) * 72 + kc * 8) = rb[1]; }
      }
    }
  };
  gload(0, ra0, rb0); gload(1, ra1, rb1);
  lstore(As0, Bs0, ra0, rb0);
  gload(2, ra0, rb0);
  __syncthreads();
  for (int kt = 0; kt < nk; kt += 2) {
    step(As0, Bs0, As1, Bs1, ra1, rb1, true);
    if (kt + 3 < nk) gload(kt + 3, ra1, rb1);
    __syncthreads();
    step(As1, Bs1, As0, Bs0, ra0, rb0, kt + 2 < nk);
    if (kt + 4 < nk) gload(kt + 4, ra0, rb0);
    __syncthreads();
  }
#pragma unroll
  for (int i = 0; i < 2; ++i)
#pragma unroll
    for (int j = 0; j < 2; ++j)
#pragma unroll
      for (int r = 0; r < 16; ++r) {
        const int row = m0 + 64 * wm + 32 * i + crow(r, h);
        const int col = n0 + 64 * wn + 32 * j + l31;
        if (MODE == 0) ((u16*)outp)[(size_t)row * LDP + col] = f2bf(acc[i][j][r]);
        else if (MODE == 1) ((u16*)outp)[(size_t)row * 1024 + col] = f2bf(acc[i][j][r]);
        else ((float*)outp)[(size_t)row * 1024 + col] = acc[i][j][r];
      }
}

template <int MODE>
DI void gemm_tile_big(const u16* __restrict__ A, int lda, const u16* __restrict__ Bt, int K, int m0, int n0, void* outp, char* smem) {
  u16* As0 = (u16*)smem;
  u16* Bs0 = As0 + 256 * 72;
  u16* As1 = Bs0 + 256 * 72;
  u16* Bs1 = As1 + 256 * 72;
  const int tid = otid(), lane = tid & 63, w = tid >> 6, h = lane >> 5, l31 = lane & 31;
  const int wm = w >> 2, wn = w & 3;
  const int lrow = tid >> 3, kc = tid & 7;
  f32x16 acc[4][2];
#pragma unroll
  for (int i = 0; i < 4; ++i)
#pragma unroll
    for (int j = 0; j < 2; ++j)
#pragma unroll
      for (int r = 0; r < 16; ++r) acc[i][j][r] = 0.f;
  u32x4 ra[4], rb[4];
  const int nk = K / 64;
  auto acol = [&](int k0) -> int {
    if (MODE == 2) return (k0 < 1024) ? (C_GG + k0) : ((k0 < 1536) ? (C_NG + k0 - 1024) : (C_MG + k0 - 1536));
    return k0;
  };
  const u16* Abase = A + (size_t)(m0 + lrow) * lda + kc * 8;
  const u16* Bbase = Bt + (size_t)(n0 + lrow) * K + kc * 8;
  auto gload = [&](int kt) {
    const int k0 = kt * 64; const int ac = acol(k0);
#pragma unroll
    for (int i = 0; i < 4; ++i) ra[i] = *(const u32x4*)(Abase + (size_t)(64 * i) * lda + ac);
#pragma unroll
    for (int i = 0; i < 4; ++i) rb[i] = *(const u32x4*)(Bbase + (size_t)(64 * i) * K + k0);
  };
  auto step = [&](const u16* AsC, const u16* BsC, u16* AsN, u16* BsN, bool do_store) {
#pragma unroll
    for (int ks = 0; ks < 4; ++ks) {
      bf16x8 a[4], b[2];
#pragma unroll
      for (int i = 0; i < 4; ++i) a[i] = *(const bf16x8*)(AsC + (128 * wm + 32 * i + l31) * 72 + 16 * ks + 8 * h);
#pragma unroll
      for (int j = 0; j < 2; ++j) b[j] = *(const bf16x8*)(BsC + (64 * wn + 32 * j + l31) * 72 + 16 * ks + 8 * h);
#pragma unroll
      for (int i = 0; i < 4; ++i)
#pragma unroll
        for (int j = 0; j < 2; ++j) acc[i][j] = MFMA32(a[i], b[j], acc[i][j]);
      if (do_store && ks == 2) {
#pragma unroll
        for (int i = 0; i < 4; ++i) *(u32x4*)(AsN + (lrow + 64 * i) * 72 + kc * 8) = ra[i];
      }
      if (do_store && ks == 3) {
#pragma unroll
        for (int i = 0; i < 4; ++i) *(u32x4*)(BsN + (lrow + 64 * i) * 72 + kc * 8) = rb[i];
      }
    }
  };
  gload(0);
#pragma unroll
  for (int i = 0; i < 4; ++i) { *(u32x4*)(As0 + (lrow + 64 * i) * 72 + kc * 8) = ra[i]; *(u32x4*)(Bs0 + (lrow + 64 * i) * 72 + kc * 8) = rb[i]; }
  gload(1);
  __syncthreads();
  for (int kt = 0; kt < nk; kt += 2) {
    step(As0, Bs0, As1, Bs1, true);
    if (kt + 2 < nk) gload(kt + 2);
    __syncthreads();
    step(As1, Bs1, As0, Bs0, kt + 2 < nk);
    if (kt + 3 < nk) gload(kt + 3);
    __syncthreads();
  }
#pragma unroll
  for (int i = 0; i < 4; ++i)
#pragma unroll
    for (int j = 0; j < 2; ++j)
#pragma unroll
      for (int r = 0; r < 16; ++r) {
        const int row = m0 + 128 * wm + 32 * i + crow(r, h);
        const int col = n0 + 64 * wn + 32 * j + l31;
        if (MODE == 0) ((u16*)outp)[(size_t)row * LDP + col] = f2bf(acc[i][j][r]);
        else ((u16*)outp)[(size_t)row * 2048 + col] = f2bf(acc[i][j][r]);
      }
}

template <bool PASS_C>
DI void gla_item(const Params& p, int slice, int item, char* smem, bool dry = false) {
  u16* Qs = (u16*)smem;
  u16* Ks = Qs + 64 * 136;
  u16* KTs = Ks + 64 * 136;
  u16* VTs = KTs + 128 * 72;
  float* LRs = (float*)(VTs + 256 * 72);
  float* TOT = LRs + 64 * 16;
  float* EB = TOT + 4 * 128;
  float* BL = EB + 128;
  float* WS = BL + 64 * 128;
  const int tid = otid(), lane = tid & 63, w = tid >> 6, h = lane >> 5, l31 = lane & 31;
  const int dir = item & 1, hh = (item >> 1) & 3, sg = item >> 3;
  const int d = tid & 127, tg = tid >> 7;
  const u16* proj = p.proj;
  const float* gw = dir ? p.gw_b : p.gw_f;
  const float* gb = dir ? p.gb_b : p.gb_f;
  u16* WTb = (u16*)WS;
  u16* LRb = (u16*)LRs;
#pragma unroll
  for (int i = 0; i < 4; ++i) { const int e = tid + 512 * i; const int dd = e >> 4, r = e & 15; WTb[e] = f2bf(gw[r * 512 + hh * 128 + dd]); }
  const float bias_z = gb[hh * 128 + 32 * (w >> 1) + l31];
  f32x16 S[4];
  float* Uit = p.U + (size_t)item * 32768;
#pragma unroll
  for (int dt = 0; dt < 4; ++dt)
#pragma unroll
    for (int r = 0; r < 16; ++r) S[dt][r] = PASS_C ? Uit[(dt * 16 + r) * 512 + tid] : 0.f;
  float dlog = 0.f;
  u16* odir = (u16*)(p.out + (size_t)slice * SL * DM) + (size_t)dir * SL * DM;
  const int lrcol = dir ? C_LRB : C_LRF;

  u32x4 pq[2], pk[2], pv[4], plr;
  auto gl_chunk = [&](int cc, int tid) {
    const int c = dir ? 7 - cc : cc;
    const int r0 = sg * 512 + c * 64;
#pragma unroll
    for (int i = 0; i < 2; ++i) {
      const int idx = tid + 512 * i; const int t = idx >> 4, c8 = idx & 15;
      pk[i] = *(const u32x4*)(proj + (size_t)(r0 + t) * LDP + C_GK + hh * 128 + c8 * 8);
      if (PASS_C) pq[i] = *(const u32x4*)(proj + (size_t)(r0 + t) * LDP + C_GQ + hh * 128 + c8 * 8);
    }
    if (tid < 128) plr = *(const u32x4*)(proj + (size_t)(r0 + (tid >> 1)) * LDP + lrcol + (tid & 1) * 8);
  };
  auto gl_chunk_v = [&](int cc, int tid) {
    const int c = dir ? 7 - cc : cc;
    const int r0 = sg * 512 + c * 64;
#pragma unroll
    for (int i = 0; i < 4; ++i) {
      const int idx = tid + 512 * i; const int t = idx >> 5, vg = idx & 31;
      pv[i] = *(const u32x4*)(proj + (size_t)(r0 + t) * LDP + C_GV + hh * 256 + vg * 8);
    }
  };
  gl_chunk(0, tid); gl_chunk_v(0, tid);
  const int tid_outer = tid;
  for (int cc = 0; cc < 8; ++cc) {
    int tid = tid_outer; asm volatile("" : "+v"(tid));
    const int lane = tid & 63, w = tid >> 6, h = lane >> 5, l31 = lane & 31, d = tid & 127, tg = tid >> 7;
    const int c = dir ? 7 - cc : cc;
    int row0 = sg * 512 + c * 64;
    asm volatile("" : "+s"(row0));
#pragma unroll
    for (int i = 0; i < 2; ++i) {
      const int idx = tid + 512 * i; const int t = idx >> 4, c8 = idx & 15;
      *(u32x4*)(Ks + t * 136 + c8 * 8) = pk[i];
      if (PASS_C) *(u32x4*)(Qs + t * 136 + c8 * 8) = pq[i];
    }
#pragma unroll
    for (int i = 0; i < 4; ++i) {
      const int idx = tid + 512 * i; const int t = idx >> 5, vg = idx & 31;
      *(u32x4*)(VTs + t * 288 + vg * 8) = pv[i];
    }
    if (tid < 128) *(u32x4*)(LRb + (tid >> 1) * 16 + (tid & 1) * 8) = plr;
    __syncthreads();
    if (cc + 1 < 8) { gl_chunk(cc + 1, tid); if (!PASS_C) gl_chunk_v(cc + 1, tid); }
    {
      const int ttz = w & 1, dz = 32 * (w >> 1) + l31;
      const bf16x8 az = *(const bf16x8*)(LRb + (32 * ttz + l31) * 16 + 8 * h);
      const bf16x8 bz = *(const bf16x8*)(WTb + dz * 16 + 8 * h);
      f32x16 z;
#pragma unroll
      for (int r = 0; r < 16; ++r) z[r] = 0.f;
      z = MFMA32(az, bz, z);
      float la[16];
#pragma unroll
      for (int r = 0; r < 16; ++r) la[r] = z[r] + bias_z;
      float ex[16];
#pragma unroll
      for (int r = 0; r < 16; ++r) ex[r] = __builtin_amdgcn_exp2f(-fabsf(la[r]) * 1.4426950408889634f);
#pragma unroll
      for (int r = 0; r < 16; ++r) ex[r] = __builtin_amdgcn_logf(1.f + ex[r]);
#pragma unroll
      for (int r = 0; r < 16; ++r) la[r] = (fminf(la[r], 0.f) - 0.6931471805599453f * ex[r]) * (1.f / 16.f);
      float G[4];
#pragma unroll
      for (int g = 0; g < 4; ++g) {
        if (dir) { la[4*g+2] += la[4*g+3]; la[4*g+1] += la[4*g+2]; la[4*g] += la[4*g+1]; G[g] = la[4*g]; }
        else     { la[4*g+1] += la[4*g];   la[4*g+2] += la[4*g+1]; la[4*g+3] += la[4*g+2]; G[g] = la[4*g+3]; }
      }
      float Go[4];
#pragma unroll
      for (int g = 0; g < 4; ++g) Go[g] = __shfl_xor(G[g], 32, 64);
      float base[4]; float runp = 0.f;
      if (dir) {
#pragma unroll
        for (int g = 3; g >= 0; --g) { base[g] = runp + (h == 0 ? Go[g] : 0.f); runp += G[g] + Go[g]; }
      } else {
#pragma unroll
        for (int g = 0; g < 4; ++g) { base[g] = runp + (h == 1 ? Go[g] : 0.f); runp += G[g] + Go[g]; }
      }
#pragma unroll
      for (int g = 0; g < 4; ++g)
#pragma unroll
        for (int r4 = 0; r4 < 4; ++r4) BL[(32 * ttz + 8 * g + 4 * h + r4) * 128 + dz] = la[4 * g + r4] + base[g];
      if (h == 0) TOT[ttz * 128 + dz] = runp;
    }
    __syncthreads();
    const float tot0 = TOT[d], tot1 = TOT[128 + d];
    const float all = tot0 + tot1;
    const float pre = dir ? ((tg < 2) ? tot1 : 0.f) : ((tg >= 2) ? tot0 : 0.f);
    {
      float bb[16], kv[16], qv[16];
#pragma unroll
      for (int u = 0; u < 16; ++u) {
        const int t = 16 * tg + u;
        bb[u] = BL[t * 128 + d] + pre;
        kv[u] = bf2f(Ks[t * 136 + d]);
        if (PASS_C) qv[u] = bf2f(Qs[t * 136 + d]);
      }
      float eb[16];
#pragma unroll
      for (int u = 0; u < 16; ++u) eb[u] = __builtin_amdgcn_exp2f(bb[u] * 1.4426950408889634f);
      unsigned kp[8];
#pragma unroll
      for (int i2 = 0; i2 < 8; ++i2) {
        kp[i2] = pack2(kv[2 * i2] * __builtin_amdgcn_rcpf(eb[2 * i2]), kv[2 * i2 + 1] * __builtin_amdgcn_rcpf(eb[2 * i2 + 1]));
        if (PASS_C) {
          const unsigned qp = pack2(qv[2 * i2] * eb[2 * i2], qv[2 * i2 + 1] * eb[2 * i2 + 1]);
          Ks[(16 * tg + 2 * i2) * 136 + d] = (u16)(kp[i2] & 0xffffu);
          Ks[(16 * tg + 2 * i2 + 1) * 136 + d] = (u16)(kp[i2] >> 16);
          Qs[(16 * tg + 2 * i2) * 136 + d] = (u16)(qp & 0xffffu);
          Qs[(16 * tg + 2 * i2 + 1) * 136 + d] = (u16)(qp >> 16);
        }
      }
      u32x4 k0, k1;
      k0[0] = kp[0]; k0[1] = kp[1]; k0[2] = kp[2]; k0[3] = kp[3];
      k1[0] = kp[4]; k1[1] = kp[5]; k1[2] = kp[6]; k1[3] = kp[7];
      *(u32x4*)(KTs + d * 72 + 16 * tg) = k0;
      *(u32x4*)(KTs + d * 72 + 16 * tg + 8) = k1;
    }
    if (tg == 0) { EB[d] = __expf(all); dlog += all; }
    __syncthreads();

    if (PASS_C) {
      f32x16 X00, X11, Xoff;
#pragma unroll
      for (int r = 0; r < 16; ++r) { X00[r] = 0.f; X11[r] = 0.f; Xoff[r] = 0.f; }
#pragma unroll 2
      for (int s = 0; s < 8; ++s) {
        bf16x8 a0 = *(const bf16x8*)(Ks + l31 * 136 + 16 * s + 8 * h);
        bf16x8 a1 = *(const bf16x8*)(Ks + (32 + l31) * 136 + 16 * s + 8 * h);
        bf16x8 b0 = *(const bf16x8*)(Qs + l31 * 136 + 16 * s + 8 * h);
        bf16x8 b1 = *(const bf16x8*)(Qs + (32 + l31) * 136 + 16 * s + 8 * h);
        X00 = MFMA32(a0, b0, X00);
        X11 = MFMA32(a1, b1, X11);
        bf16x8 ao = dir ? a1 : a0, bo = dir ? b0 : b1;
        Xoff = MFMA32(ao, bo, Xoff);
      }
      {
        int lo = l31 - 4 * h;
        asm volatile("" : "+v"(lo));
#pragma unroll
        for (int r = 0; r < 16; ++r) {
          const int j = (r & 3) + 8 * (r >> 2);
          const bool keep = dir ? (j >= lo) : (j <= lo);
          X00[r] = keep ? X00[r] : 0.f; X11[r] = keep ? X11[r] : 0.f;
        }
      }
      const bf16x8 x00a = pack8<0>(X00), x00b = pack8<1>(X00), x11a = pack8<0>(X11), x11b = pack8<1>(X11),
                   xofa = pack8<0>(Xoff), xofb = pack8<1>(Xoff);
      const bf16x8 vp00 = tr_frag(VTs, 288, 32 * w, 0 + 4 * h, 8 + 4 * h, lane), vp01 = tr_frag(VTs, 288, 32 * w, 16 + 4 * h, 24 + 4 * h, lane),
                   vp10 = tr_frag(VTs, 288, 32 * w, 32 + 4 * h, 40 + 4 * h, lane), vp11 = tr_frag(VTs, 288, 32 * w, 48 + 4 * h, 56 + 4 * h, lane);
#pragma unroll
      for (int it = 0; it < 2; ++it) {
        f32x16 acc;
#pragma unroll
        for (int r = 0; r < 16; ++r) acc[r] = 0.f;
        const u16* qrow = Qs + (32 * it + l31) * 136;
#pragma unroll
        for (int dt = 0; dt < 4; ++dt) {
          acc = MFMA32(ld_perm(qrow + 32 * dt, 0, h), pack8<0>(S[dt]), acc);
          acc = MFMA32(ld_perm(qrow + 32 * dt, 1, h), pack8<1>(S[dt]), acc);
        }
        if (it == 0) {
          acc = MFMA32(x00a, vp00, acc);
          acc = MFMA32(x00b, vp01, acc);
          if (dir) {
            acc = MFMA32(xofa, vp10, acc);
            acc = MFMA32(xofb, vp11, acc);
          }
        } else {
          acc = MFMA32(x11a, vp10, acc);
          acc = MFMA32(x11b, vp11, acc);
          if (!dir) {
            acc = MFMA32(xofa, vp00, acc);
            acc = MFMA32(xofb, vp01, acc);
          }
        }
#pragma unroll
        for (int r = 0; r < 16; ++r)
          if (!dry) odir[(size_t)(row0 + 32 * it + crow(r, h)) * DM + hh * 256 + 32 * w + l31] = f2bf(acc[r]);
      }
    }
    if (PASS_C && cc + 1 < 8) gl_chunk_v(cc + 1, tid);
    bf16x8 vb[4];
#pragma unroll
    for (int ks = 0; ks < 4; ++ks) vb[ks] = tr_frag(VTs, 288, 32 * w, 16 * ks + 8 * h, 16 * ks + 8 * h + 4, lane);
#pragma unroll
    for (int dt = 0; dt < 4; ++dt) {
#pragma unroll
      for (int ks = 0; ks < 4; ++ks) {
        bf16x8 a = *(const bf16x8*)(KTs + (32 * dt + l31) * 72 + 16 * ks + 8 * h);
        S[dt] = MFMA32(a, vb[ks], S[dt]);
      }
#pragma unroll
      for (int g = 0; g < 4; ++g) {
        f32x4 e = *(const f32x4*)(EB + 32 * dt + 8 * g + 4 * h);
        S[dt][4 * g + 0] *= e[0]; S[dt][4 * g + 1] *= e[1]; S[dt][4 * g + 2] *= e[2]; S[dt][4 * g + 3] *= e[3];
      }
    }
    __syncthreads();
  }
  if (!PASS_C) {
#pragma unroll
    for (int dt = 0; dt < 4; ++dt)
#pragma unroll
      for (int r = 0; r < 16; ++r) Uit[(dt * 16 + r) * 512 + tid] = S[dt][r];
    if (tg == 0) p.Dlog[item * 128 + d] = dlog;
  }
}

DI void gla_pass_b(const Params& p, int slice) {
  const int nseq = slice == 0 ? 1 : 2, segs = slice == 0 ? 32 : 16;
  const int total = nseq * 8 * 32768;
  for (int e = blockIdx.x * NT + otid(); e < total; e += gridDim.x * NT) {
    const int elem = e & 32767, hd = (e >> 15) & 7, sq = e >> 18;
    const int dir = hd & 1;
    const int t = elem & 511, dtreg = elem >> 9;
    const int hl = (t & 63) >> 5;
    const int d = 32 * (dtreg >> 4) + crow(dtreg & 15, hl);
    float carry = 0.f;
    for (int i0 = 0; i0 < segs; i0 += 16) {
      float u[16], dl[16];
#pragma unroll
      for (int k = 0; k < 16; ++k) {
        const int sgl = dir ? segs - 1 - (i0 + k) : (i0 + k);
        const int it = (sq * segs + sgl) * 8 + hd;
        u[k] = p.U[(size_t)it * 32768 + elem];
        dl[k] = p.Dlog[it * 128 + d];
      }
#pragma unroll
      for (int k = 0; k < 16; ++k) {
        const int sgl = dir ? segs - 1 - (i0 + k) : (i0 + k);
        const int it = (sq * segs + sgl) * 8 + hd;
        p.U[(size_t)it * 32768 + elem] = carry;
        carry = __expf(dl[k]) * carry + u[k];
      }
    }
  }
}

DI void gla_combine(const Params& p, int slice) {
  const int lane = otid() & 63, w = otid() >> 6;
  const int nw = gridDim.x * (NT / 64);
  const u16* of = (const u16*)(p.out + (size_t)slice * SL * DM);
  const u16* ob = of + (size_t)SL * DM;
  const int col = (lane >> 4) * 256 + (lane & 15) * 16;
  float ng[16];
#pragma unroll
  for (int i = 0; i < 4; ++i) { f32x4 t4 = *(const f32x4*)(p.gla_ng + (lane & 15) * 16 + 4 * i); ng[4*i] = t4[0]; ng[4*i+1] = t4[1]; ng[4*i+2] = t4[2]; ng[4*i+3] = t4[3]; }
  for (int row0 = (blockIdx.x * (NT / 64) + w) * 4; row0 < SL; row0 += nw * 4) {
    bf16x8 a0[4], a1[4], b0[4], b1[4], g0[4], g1[4];
#pragma unroll
    for (int u = 0; u < 4; ++u) {
      const int row = row0 + u;
      a0[u] = *(const bf16x8*)(of + (size_t)row * DM + col); a1[u] = *(const bf16x8*)(of + (size_t)row * DM + col + 8);
      b0[u] = *(const bf16x8*)(ob + (size_t)row * DM + col); b1[u] = *(const bf16x8*)(ob + (size_t)row * DM + col + 8);
      const u16* gp = p.proj + (size_t)row * LDP + C_GG + col;
      g0[u] = *(const bf16x8*)gp; g1[u] = *(const bf16x8*)(gp + 8);
    }
#pragma unroll
    for (int u = 0; u < 4; ++u) {
      u16* gp = p.proj + (size_t)(row0 + u) * LDP + C_GG + col;
      float o[16]; float ss = 0.f;
#pragma unroll
      for (int i = 0; i < 8; ++i) {
        o[i] = bf2f((u16)a0[u][i]) + bf2f((u16)b0[u][i]); o[8 + i] = bf2f((u16)a1[u][i]) + bf2f((u16)b1[u][i]);
        ss += o[i] * o[i] + o[8 + i] * o[8 + i];
      }
#pragma unroll
      for (int m = 8; m > 0; m >>= 1) ss += __shfl_xor(ss, m, 64);
      const float rstd = rsqrtf(ss * (1.f / 256.f) + 1e-6f);
      u32x4 r0, r1;
#pragma unroll
      for (int i = 0; i < 4; ++i) {
        r0[i] = pack2(o[2*i] * rstd * ng[2*i] * silu(bf2f((u16)g0[u][2*i])), o[2*i+1] * rstd * ng[2*i+1] * silu(bf2f((u16)g0[u][2*i+1])));
        r1[i] = pack2(o[8+2*i] * rstd * ng[8+2*i] * silu(bf2f((u16)g1[u][2*i])), o[8+2*i+1] * rstd * ng[8+2*i+1] * silu(bf2f((u16)g1[u][2*i+1])));
      }
      *(u32x4*)gp = r0; *(u32x4*)(gp + 8) = r1;
    }
  }
}

DI void nat_item(const Params& p, int slice, int item, char* smem, bool dry = false) {
  const int tid = otid(), lane = tid & 63, w = tid >> 6, h = lane >> 5, l31 = lane & 31;
  u16* VT = (u16*)smem + w * (64 * 96);
  float* SC = (float*)(smem + 8 * 64 * 96 * 2) + w * 64;
  float* BIAS = (float*)(smem + 8 * 64 * 96 * 2 + 8 * 64 * 4) + w * 480;
  const int nh = item & 7, R = item >> 3;
  const int rows = slice == 0 ? 256 : 128;
  const int sq = R / rows, r = R % rows;
  const int rs = min(max(r - 4, 0), rows - 8);
  const int seq0 = sq * rows * 64;
  const int qrow0 = seq0 + r * 64;
  u16* proj = p.proj;
  for (int i = lane; i < 465; i += 64) BIAS[i] = p.rpb[nh * 465 + i];
  bf16x8 bq[2][4];
#pragma unroll
  for (int qt = 0; qt < 2; ++qt)
#pragma unroll
    for (int s = 0; s < 4; ++s) bq[qt][s] = *(const bf16x8*)(proj + (size_t)(qrow0 + 32 * qt + l31) * LDP + C_NQ + nh * 64 + 16 * s + 8 * h);
  f32x16 o[2][2];
#pragma unroll
  for (int a = 0; a < 2; ++a)
#pragma unroll
    for (int b = 0; b < 2; ++b)
#pragma unroll
      for (int rr = 0; rr < 16; ++rr) o[a][b][rr] = 0.f;
  float mrun[2] = {-1e30f, -1e30f}, lrun[2] = {0.f, 0.f};
  unsigned vmask[2];
#pragma unroll
  for (int qt = 0; qt < 2; ++qt) {
    const int cq = 32 * qt + l31;
    const int cs = min(max(cq - 8, 0), 48);
    unsigned m = 0u;
#pragma unroll
    for (int kt = 0; kt < 2; ++kt)
#pragma unroll
      for (int rr = 0; rr < 16; ++rr) {
        const int ck = 32 * kt + crow(rr, h);
        m |= ((ck >= cs) && (ck < cs + 16)) ? (1u << (kt * 16 + rr)) : 0u;
      }
    vmask[qt] = m;
  }
  bf16x8 ka[2][4]; u32x4 vc[8];
  auto ld_row = [&](int kk, bf16x8 (&kf)[2][4], u32x4 (&vr)[8]) {
    const int kr0 = seq0 + (rs + kk) * 64;
#pragma unroll
    for (int i = 0; i < 8; ++i) {
      const int idx = lane + 64 * i; const int key = idx >> 3, dg = idx & 7;
      vr[i] = *(const u32x4*)(proj + (size_t)(kr0 + key) * LDP + C_NV + nh * 64 + dg * 8);
    }
#pragma unroll
    for (int kt = 0; kt < 2; ++kt)
#pragma unroll
      for (int s = 0; s < 4; ++s) kf[kt][s] = *(const bf16x8*)(proj + (size_t)(kr0 + 32 * kt + l31) * LDP + C_NK + nh * 64 + 16 * s + 8 * h);
  };
#pragma unroll 1
  for (int kk = 0; kk < 8; ++kk) {
    ld_row(kk, ka, vc);
#pragma unroll
    for (int i = 0; i < 8; ++i) {
      const int idx = lane + 64 * i; const int key = idx >> 3, dg = idx & 7;
      *(u32x4*)(VT + key * 96 + dg * 8) = vc[i];
    }
    f32x16 acc[2][2];
#pragma unroll
    for (int a = 0; a < 2; ++a)
#pragma unroll
      for (int b = 0; b < 2; ++b)
#pragma unroll
        for (int rr = 0; rr < 16; ++rr) acc[a][b][rr] = 0.f;
#pragma unroll
    for (int s = 0; s < 4; ++s)
#pragma unroll
      for (int kt = 0; kt < 2; ++kt)
#pragma unroll
        for (int qt = 0; qt < 2; ++qt) acc[kt][qt] = MFMA32(ka[kt][s], bq[qt][s], acc[kt][qt]);
    const int drow = rs + kk - r + 7;
#pragma unroll
    for (int qt = 0; qt < 2; ++qt) {
      const int cq = 32 * qt + l31;
      const float* bp = BIAS + drow * 31 + (15 - cq + 4 * h);
      float mx = -1e30f;
#pragma unroll
      for (int kt = 0; kt < 2; ++kt)
#pragma unroll
        for (int rr = 0; rr < 16; ++rr) {
          const float sc = acc[kt][qt][rr] + bp[32 * kt + (rr & 3) + 8 * (rr >> 2)];
          acc[kt][qt][rr] = ((vmask[qt] >> (kt * 16 + rr)) & 1u) ? sc : -1e30f;
          mx = fmaxf(mx, acc[kt][qt][rr]);
        }
      mx = fmaxf(mx, __shfl_xor(mx, 32, 64));
      const float mnew = fmaxf(mrun[qt], mx);
      const float alpha = __expf(mrun[qt] - mnew);
      mrun[qt] = mnew;
      float ls = 0.f;
#pragma unroll
      for (int kt = 0; kt < 2; ++kt)
#pragma unroll
        for (int rr = 0; rr < 16; ++rr) { float e = __expf(acc[kt][qt][rr] - mnew); acc[kt][qt][rr] = e; ls += e; }
      ls += __shfl_xor(ls, 32, 64);
      lrun[qt] = lrun[qt] * alpha + ls;
#pragma unroll
      for (int dt = 0; dt < 2; ++dt)
#pragma unroll
        for (int rr = 0; rr < 16; ++rr) o[qt][dt][rr] *= alpha;
    }
    bf16x8 vf[2][4];
#pragma unroll
    for (int dt = 0; dt < 2; ++dt) {
      vf[dt][0] = tr_frag(VT, 96, 32 * dt, 0 + 4 * h, 8 + 4 * h, lane);   vf[dt][1] = tr_frag(VT, 96, 32 * dt, 16 + 4 * h, 24 + 4 * h, lane);
      vf[dt][2] = tr_frag(VT, 96, 32 * dt, 32 + 4 * h, 40 + 4 * h, lane); vf[dt][3] = tr_frag(VT, 96, 32 * dt, 48 + 4 * h, 56 + 4 * h, lane);
    }
#pragma unroll
    for (int qt = 0; qt < 2; ++qt) {
      const bf16x8 p00 = pack8<0>(acc[0][qt]), p01 = pack8<1>(acc[0][qt]), p10 = pack8<0>(acc[1][qt]), p11 = pack8<1>(acc[1][qt]);
#pragma unroll
      for (int dt = 0; dt < 2; ++dt) {
        o[qt][dt] = MFMA32(vf[dt][0], p00, o[qt][dt]);
        o[qt][dt] = MFMA32(vf[dt][1], p01, o[qt][dt]);
        o[qt][dt] = MFMA32(vf[dt][2], p10, o[qt][dt]);
        o[qt][dt] = MFMA32(vf[dt][3], p11, o[qt][dt]);
      }
    }
  }
#pragma unroll
  for (int qt = 0; qt < 2; ++qt) {
    const float inv = 1.f / lrun[qt];
    u16* rowp = proj + (size_t)(qrow0 + 32 * qt + l31) * LDP + C_NG + nh * 64;
#pragma unroll
    for (int dt = 0; dt < 2; ++dt)
#pragma unroll
      for (int g = 0; g < 4; ++g) {
        u16* gp = rowp + 32 * dt + 8 * g + 4 * h;
        const bf16x4 gt = *(const bf16x4*)gp;
        u32x2 res;
        res[0] = pack2(o[qt][dt][4 * g + 0] * inv * silu(bf2f((u16)gt[0])), o[qt][dt][4 * g + 1] * inv * silu(bf2f((u16)gt[1])));
        res[1] = pack2(o[qt][dt][4 * g + 2] * inv * silu(bf2f((u16)gt[2])), o[qt][dt][4 * g + 3] * inv * silu(bf2f((u16)gt[3])));
        if (!dry) *(u32x2*)gp = res;
      }
  }
}

DI void mem_item(const Params& p, int slice, int item, char* smem, bool dry = false) {
  const int tid = otid(), lane = tid & 63, w = tid >> 6, h = lane >> 5, l31 = lane & 31;
  u16* VT = (u16*)smem;
  u16* KM = VT + 256 * 144;
  const int mh = item & 3, tb = item >> 2;
  const int batch = slice == 0 ? 0 : (tb < 32 ? 1 : 2);
  const u16* mkv = p.mkv + (size_t)batch * 256 * 1024;
  u16* proj = p.proj;
#pragma unroll
  for (int i = 0; i < 8; ++i) {
    int idx = tid + 512 * i; int key = idx >> 4, dg = idx & 15;
    *(u32x4*)(VT + key * 144 + dg * 8) = *(const u32x4*)(mkv + (size_t)key * 1024 + 512 + mh * 128 + dg * 8);
    *(u32x4*)(KM + key * 136 + dg * 8) = *(const u32x4*)(mkv + (size_t)key * 1024 + mh * 128 + dg * 8);
  }
  const int qrow = tb * 256 + 32 * w + l31;
  bf16x8 bq[8];
#pragma unroll
  for (int s = 0; s < 8; ++s) bq[s] = *(const bf16x8*)(proj + (size_t)qrow * LDP + C_MQ + mh * 128 + 16 * s + 8 * h);
  float* LB = (float*)(smem + 256 * 144 * 2 + 256 * 136 * 2) + w * 32;
  constexpr float kDefer = 8.f;
  float m = -1e30f;
  __syncthreads();
  f32x16 o[4];
#pragma unroll
  for (int dt = 0; dt < 4; ++dt)
#pragma unroll
    for (int rr = 0; rr < 16; ++rr) o[dt][rr] = 0.f;
  float l = 0.f;
#pragma unroll 1
  for (int kt = 0; kt < 8; ++kt) {
    f32x16 acc;
#pragma unroll
    for (int rr = 0; rr < 16; ++rr) acc[rr] = 0.f;
#pragma unroll
    for (int s = 0; s < 8; ++s) {
      bf16x8 a = *(const bf16x8*)(KM + (32 * kt + l31) * 136 + 16 * s + 8 * h);
      acc = MFMA32(a, bq[s], acc);
    }
    float mx = acc[0];
#pragma unroll
    for (int rr = 1; rr < 16; ++rr) mx = fmaxf(mx, acc[rr]);
    mx = fmaxf(mx, __shfl_xor(mx, 32, 64));
    const bool need = mx > m + kDefer;
    if (__any(need)) {
      const float mnew = need ? mx : m;
      const float alpha = __expf(m - mnew);
      m = mnew; l *= alpha;
#pragma unroll
      for (int dt = 0; dt < 4; ++dt)
#pragma unroll
        for (int rr = 0; rr < 16; ++rr) o[dt][rr] *= alpha;
    }
#pragma unroll
    for (int rr = 0; rr < 16; ++rr) { float e = __expf(acc[rr] - m); acc[rr] = e; l += e; }
    const bf16x8 p0 = pack8<0>(acc), p1 = pack8<1>(acc);
#pragma unroll
    for (int dt = 0; dt < 4; ++dt) {
      o[dt] = MFMA32(tr_frag(VT, 144, 32 * dt, 32 * kt + 4 * h, 32 * kt + 8 + 4 * h, lane), p0, o[dt]);
      o[dt] = MFMA32(tr_frag(VT, 144, 32 * dt, 32 * kt + 16 + 4 * h, 32 * kt + 24 + 4 * h, lane), p1, o[dt]);
    }
  }
  l += __shfl_xor(l, 32, 64);
  {
    const float inv = 1.f / l;
    u16* rowp = proj + (size_t)(tb * 256 + 32 * w + l31) * LDP + C_MG + mh * 128;
#pragma unroll
    for (int dt = 0; dt < 4; ++dt)
#pragma unroll
      for (int g = 0; g < 4; ++g) {
        u16* gp = rowp + 32 * dt + 8 * g + 4 * h;
        const bf16x4 gt = *(const bf16x4*)gp;
        u32x2 res;
        res[0] = pack2(o[dt][4 * g + 0] * inv * silu(bf2f((u16)gt[0])), o[dt][4 * g + 1] * inv * silu(bf2f((u16)gt[1])));
        res[1] = pack2(o[dt][4 * g + 2] * inv * silu(bf2f((u16)gt[2])), o[dt][4 * g + 3] * inv * silu(bf2f((u16)gt[3])));
        if (!dry) *(u32x2*)gp = res;
      }
  }
  __syncthreads();
}

DI void final_norm(const Params& p, int slice, int wi, int wc) {
  const int lane = otid() & 63, w = otid() >> 6;
  const int nw = wc * (NT / 64);
  f32x4 g[4];
#pragma unroll
  for (int i = 0; i < 4; ++i) g[i] = *(const f32x4*)(p.post_g + (i * 64 + lane) * 4);
  for (int r0 = (wi * (NT / 64) + w) * 4; r0 < SL; r0 += nw * 4) {
    bf16x4 vb[4][4]; f32x4 xq[4][4];
#pragma unroll
    for (int u = 0; u < 4; ++u) {
      const u16* o = (const u16*)(p.out + ((size_t)slice * SL + r0 + u) * DM);
      const float* xs = p.x[slice] + (size_t)(r0 + u) * DM;
#pragma unroll
      for (int i = 0; i < 4; ++i) { vb[u][i] = __builtin_nontemporal_load((const bf16x4*)(o + (i * 64 + lane) * 4)); xq[u][i] = __builtin_nontemporal_load((const f32x4*)(xs + (i * 64 + lane) * 4)); }
    }
    float rstd[4];
#pragma unroll
    for (int u = 0; u < 4; ++u) {
      float ss = 0.f;
#pragma unroll
      for (int i = 0; i < 4; ++i)
#pragma unroll
        for (int c = 0; c < 4; ++c) { const float v = bf2f((u16)vb[u][i][c]); ss += v * v; }
      ss = wave_sum(ss);
      rstd[u] = rsqrtf(ss * (1.f / DM) + 1e-6f);
    }
#pragma unroll
    for (int u = 0; u < 4; ++u) {
      float* o = p.out + ((size_t)slice * SL + r0 + u) * DM;
#pragma unroll
      for (int i = 0; i < 4; ++i) {
        f32x4 y;
#pragma unroll
        for (int c = 0; c < 4; ++c) y[c] = xq[u][i][c] + bf2f((u16)vb[u][i][c]) * rstd[u] * g[i][c];
        __builtin_nontemporal_store(y, (f32x4*)(o + (i * 64 + lane) * 4));
      }
    }
  }
}

DI int xq(int v, int G, int& x) { const int b = v % G, i = v / G; x = b & 7; return (b >> 3) + (G >> 3) * i; }
DI void map_p1(int v, int G, int& m, int& n) {
  if (G != 256) { m = v / 49; n = v % 49; return; }
  int x; const int q = xq(v, G, x);
  if (q >= 392) { m = -1; n = 0; return; }
  const int mh = q / 196, rem = q % 196;
  n = rem >> 2; m = 8 * x + 4 * mh + (rem & 3);
}
DI void map_out(int v, int G, int& m, int& n) {
  if (G != 256) { m = v / 8; n = v % 8; return; }
  int x; const int q = xq(v, G, x);
  if (q >= 64) { m = -1; n = 0; return; }
  n = (q >> 2) & 7; m = 8 * x + 4 * (q >> 5) + (q & 3);
}
DI void map_p1_big(int v, int G, int& m, int& n) {
  if (G != 256) { m = v / 24; n = v % 24; return; }
  int x; const int q = xq(v, G, x);
  if (q >= 192) { m = -1; n = 0; return; }
  n = q >> 3; m = 8 * x + (q & 7);
}
DI void map_out_big(int v, int G, int& m, int& n) {
  if (G != 256) { m = v / 4; n = v % 4; return; }
  int x; const int q = xq(v, G, x);
  if (q >= 32) { m = -1; n = 0; return; }
  n = (q >> 2) & 3; m = 8 * x + 4 * (q >> 4) + (q & 3);
}
DI int map_gla(int v, int G) {
  if (G != 256) return v;
  int x; const int q = xq(v, G, x);
  if (q >= 32) return -1;
  return (4 * x + (q >> 3)) * 8 + (q & 7);
}
DI int map_natrow(int v, int G) {
  if (G != 256) return v;
  int x; const int q = xq(v, G, x);
  if (q >= 32) return -1;
  return 32 * x + q;
}
#define GSYNC() do { xcd_barrier(xb); if (DUP & 64) xcd_barrier(xb); } while (0)
__global__ void __launch_bounds__(NT) mega_kernel(Params p) {
  __shared__ __attribute__((aligned(16))) char smem[SMEM_BYTES];
  __shared__ uint4 xb_words;
  cg::grid_group grid = cg::this_grid();
  const int G = gridDim.x, B = blockIdx.x;
  if (threadIdx.x == 0) xb_words = make_uint4(0u, 0u, 0u, 0u);
  __syncthreads();
  const XcdBarrier xb = xcd_barrier_post(p.bar, (volatile LAS unsigned*)&xb_words);

  if (PH & 1) phase0(p, smem);
  if (DUP & 32) phase0(p, smem);
  if (p.use_cg_sync) grid.sync(); else GSYNC();
#pragma unroll 1
  for (int s = 0; s < 2; ++s) {
    {
      const u16* hA = (const u16*)(p.out + (size_t)s * SL * DM);
      if (PH & 2) {
        const int w_lo = (G == 256) ? (s == 0 ? 88 : 64) : 0;
        const int wi = B - w_lo, wc = G - w_lo;
        const int extra_at = (B >> 3) % 6; int ti = 0; bool extra_done = (wi < 0);
        for (int rp = 1; rp < p.rep_p1; ++rp)
          for (int t = B; t < 64 * 24; t += G) { int m, n; map_p1_big(t, G, m, n); if (m < 0 || m >= 64) break; gemm_tile_big<0>(hA, DM, p.wt_in, 1024, m * 256, n * 256, p.proj, smem); }
        for (int t = B; t < 64 * 24; t += G, ++ti) {
          if (ti == extra_at && !extra_done) { if (s == 0) { prep_rows(p, SL, 2 * SL, wi, wc); prep_wout(p, smem, wi, wc); } else if (PH & 8) final_norm(p, 0, wi, wc); extra_done = true; }
          int m, n; map_p1_big(t, G, m, n); if (m < 0 || m >= 64) break; gemm_tile_big<0>(hA, DM, p.wt_in, 1024, m * 256, n * 256, p.proj, smem);
        }
        if (!extra_done) { if (s == 0) { prep_rows(p, SL, 2 * SL, wi, wc); prep_wout(p, smem, wi, wc); } else if (PH & 8) final_norm(p, 0, wi, wc); }
        for (int t = B; t < 64; t += G) gemm_tile<0>(hA, DM, p.wt_in, 1024, t * 256, 6144, p.proj, smem);
      }
      if (DUP & 8) {
        for (int t = B; t < 64 * 24; t += G) { int m, n; map_p1_big(t, G, m, n); if (m < 0 || m >= 64) break; gemm_tile_big<0>(hA, DM, p.wt_in, 1024, m * 256, n * 256, p.proj, smem); }
        for (int t = B; t < 64; t += G) gemm_tile<0>(hA, DM, p.wt_in, 1024, t * 256, 6144, p.proj, smem);
      }
      if (s == 0) {
        if (PH & 4) for (int t = (B >= 64 ? B - 64 : B + G - 64); t < 3 * 8; t += G) gemm_tile<1>(p.hm, DM, p.wt_kv, 1024, (t / 8) * 256, (t % 8) * 128, p.mkv, smem);
      }
    }
    GSYNC();
    {
      const bool gla_first = ((B >> 3) & 1) == 0;
#pragma unroll 1
      for (int st = 0; st < 2; ++st) {
        if ((st == 0) == gla_first) {
          if (PH & 16) for (int t = B; t < 256; t += G) { const int it = map_gla(t, G); if (it < 0) break; gla_item<false>(p, s, it, smem); }
        } else {
          if (PH & 32) { for (int t = B; t < 256; t += G) { const int R = map_natrow(t, G); if (R < 0) break; nat_item(p, s, R * 8 + (otid() >> 6), smem); } __syncthreads(); }
          if (PH & 64) for (int t = B; t < 256; t += G) mem_item(p, s, t, smem);
        }
      }
    }
    GSYNC();
    if (PH & 128) gla_pass_b(p, s);
    GSYNC();
    if (PH & 256) for (int t = B; t < 256; t += G) { const int it = map_gla(t, G); if (it < 0) break; gla_item<true>(p, s, it, smem); }
    if (DUP & (1 | 512)) for (int t = B; t < 256; t += G) { const int it = map_gla(t, G); if (it < 0) break; gla_item<true>(p, s, it, smem); }
    if (DUP & 1024) for (int t = B; t < 256; t += G) { const int it = map_gla(t, G); if (it < 0) break; gla_item<true>(p, s, it, smem, p.dry != 0); }
    GSYNC();
    if (PH & 512) gla_combine(p, s);
    GSYNC();
    {
      float* od = p.out + (size_t)s * SL * DM;
      if (PH & 1024) for (int t = B; t < 64 * 4; t += G) { int m, n; map_out_big(t, G, m, n); if (m < 0 || m >= 64) break; gemm_tile_big<2>(p.proj, LDP, p.wt_out, 2048, m * 256, n * 256, od, smem); }
      if (DUP & 16) for (int t = B; t < 64 * 4; t += G) { int m, n; map_out_big(t, G, m, n); if (m < 0 || m >= 64) break; gemm_tile_big<2>(p.proj, LDP, p.wt_out, 2048, m * 256, n * 256, od, smem); }
    }
    GSYNC();
  }
  if (PH & 8) final_norm(p, 1, B, G);
}

extern "C" void kernel_launch(void* const* d_in, const int* in_sizes, int n_in, void* d_out, int out_size, void* d_ws,
                              size_t ws_size, hipStream_t stream) {
  static int grid_blocks = 0;
  if (!grid_blocks) {
    int dev = 0, cus = 0, per_cu = 0;
    hipGetDevice(&dev);
    hipDeviceGetAttribute(&cus, hipDeviceAttributeMultiprocessorCount, dev);
    hipOccupancyMaxActiveBlocksPerMultiprocessor(&per_cu, mega_kernel, NT, 0);
    if (per_cu < 1) per_cu = 1;
    if (per_cu > 1) per_cu = 1;
    grid_blocks = cus * per_cu;
  }
  Params p{};
  p.x[0] = (const float*)d_in[0]; p.x[1] = (const float*)d_in[1];
  p.mem[0] = (const float*)d_in[2]; p.mem[1] = (const float*)d_in[3];
  p.pre_g = (const float*)d_in[4]; p.w_in = (const float*)d_in[5];
  p.gw_f = (const float*)d_in[6]; p.gb_f = (const float*)d_in[7];
  p.gw_b = (const float*)d_in[8]; p.gb_b = (const float*)d_in[9];
  p.gla_ng = (const float*)d_in[10]; p.rpb = (const float*)d_in[11];
  p.mem_ng = (const float*)d_in[12]; p.w_kv = (const float*)d_in[13];
  p.w_out = (const float*)d_in[14]; p.post_g = (const float*)d_in[15];
  p.out = (float*)d_out;
  p.dry = 1;
  p.rep_p1 = REP_P1;
  p.use_cg_sync = 0;
  char* ws = (char*)d_ws; size_t off = 0;
  auto take = [&](size_t bytes) { char* r = ws + off; off += (bytes + 255) & ~(size_t)255; return r; };
  p.proj = (u16*)take((size_t)SL * LDP * 2);
  p.U = (float*)take((size_t)256 * 32768 * 4);
  p.Dlog = (float*)take((size_t)256 * 128 * 4);
  p.wt_in = (u16*)take((size_t)LDP * 1024 * 2);
  p.wt_kv = (u16*)take((size_t)1024 * 1024 * 2);
  p.wt_out = (u16*)take((size_t)1024 * 2048 * 2);
  p.hm = (u16*)take((size_t)768 * 1024 * 2);
  p.mkv = (u16*)take((size_t)768 * 1024 * 2);
  p.bar = (unsigned*)take((size_t)XCD_BAR_WORDS * 4);
  if (off > ws_size) { fprintf(stderr, "workspace too small: need %zu have %zu\n", off, ws_size); return; }
  hipMemsetAsync(p.bar, 0, (size_t)XCD_BAR_WORDS * 4, stream);
  void* args[] = {&p};
  hipError_t e = hipLaunchCooperativeKernel((void*)mega_kernel, dim3(grid_blocks), dim3(NT), args, 0, stream);
  if (e != hipSuccess) fprintf(stderr, "cooperative launch failed: %s (grid %d)\n", hipGetErrorString(e), grid_blocks);
}
```

```cpp
#include <hip/hip_runtime.h>
#include <hip/hip_cooperative_groups.h>
#include <cstdio>
namespace cg = cooperative_groups;

typedef unsigned short u16;
typedef __attribute__((ext_vector_type(8))) short bf16x8;
typedef __attribute__((ext_vector_type(4))) short bf16x4;
typedef __attribute__((ext_vector_type(16))) float f32x16;
typedef __attribute__((ext_vector_type(4))) float f32x4;
typedef __attribute__((ext_vector_type(4))) unsigned u32x4;
typedef __attribute__((ext_vector_type(2))) unsigned u32x2;

#define DI __device__ __forceinline__
#define MFMA32(a, b, c) __builtin_amdgcn_mfma_f32_32x32x16_bf16((a), (b), (c), 0, 0, 0)

static constexpr int NT = 512;
static constexpr int SL = 16384;
static constexpr int DM = 1024;
static constexpr int LDP = 6272;
static constexpr int C_GQ = 0, C_GK = 512, C_GV = 1024, C_GG = 2048, C_NQ = 3072, C_NK = 3584, C_NV = 4096,
                     C_NG = 4608, C_MQ = 5120, C_MG = 5632, C_LRF = 6144, C_LRB = 6160;
static constexpr int SMEM_BYTES = 144 * 1024;
#ifndef PH
#define PH 0xFFF
#endif
#ifndef DUP
#define DUP 0
#endif
#ifndef REP_P1
#define REP_P1 1
#endif

struct Params {
  const float* x[2];
  const float* mem[2];
  const float *pre_g, *w_in, *gw_f, *gb_f, *gw_b, *gb_b, *gla_ng, *rpb, *mem_ng, *w_kv, *w_out, *post_g;
  float* out;
  u16 *proj, *wt_in, *wt_kv, *wt_out, *hm, *mkv;
  float *U, *Dlog;
  unsigned* bar;
  int dry; int rep_p1; int use_cg_sync; int pad3_;
};

typedef __attribute__((ext_vector_type(2))) __bf16 bf16v2;
typedef __attribute__((ext_vector_type(2))) float f32x2;
DI unsigned pack2(float a, float b) { f32x2 v; v[0] = a; v[1] = b; return __builtin_bit_cast(unsigned, __builtin_convertvector(v, bf16v2)); }
DI u16 f2bf(float x) { return (u16)(pack2(x, 0.f) & 0xffffu); }
DI float bf2f(u16 v) { return __uint_as_float(((unsigned)v) << 16); }
DI int otid() { int t = (int)threadIdx.x; asm volatile("" : "+v"(t)); return t; }
DI int crow(int reg, int h) { return (reg & 3) + 8 * (reg >> 2) + 4 * h; }
DI float silu(float g) { return g * __builtin_amdgcn_rcpf(1.f + __expf(-g)); }
DI float wave_sum(float v) {
#pragma unroll
  for (int o = 32; o > 0; o >>= 1) v += __shfl_xor(v, o, 64);
  return v;
}
template <int S> DI bf16x8 pack8(const f32x16& x) {
  u32x4 p;
  p[0] = pack2(x[8 * S + 0], x[8 * S + 1]); p[1] = pack2(x[8 * S + 2], x[8 * S + 3]);
  p[2] = pack2(x[8 * S + 4], x[8 * S + 5]); p[3] = pack2(x[8 * S + 6], x[8 * S + 7]);
  return __builtin_bit_cast(bf16x8, p);
}
DI bf16x8 ld_perm(const u16* rowbase, int s, int h) {
  bf16x4 lo = *(const bf16x4*)(rowbase + 16 * s + 4 * h);
  bf16x4 hi = *(const bf16x4*)(rowbase + 16 * s + 8 + 4 * h);
  return __builtin_shufflevector(lo, hi, 0, 1, 2, 3, 4, 5, 6, 7);
}


DI bf16x8 gather_nat(const u16* colp, int ld, int k0) {
  u32x4 r;
#pragma unroll
  for (int j = 0; j < 4; ++j) r[j] = (unsigned)colp[(k0 + 2 * j) * ld] | ((unsigned)colp[(k0 + 2 * j + 1) * ld] << 16);
  return __builtin_bit_cast(bf16x8, r);
}
DI bf16x8 gather_perm(const u16* colp, int ld, int kb, int s, int h) {
  const int k0 = kb + 16 * s + 4 * h;
  u32x4 r;
  r[0] = (unsigned)colp[(k0 + 0) * ld] | ((unsigned)colp[(k0 + 1) * ld] << 16);
  r[1] = (unsigned)colp[(k0 + 2) * ld] | ((unsigned)colp[(k0 + 3) * ld] << 16);
  r[2] = (unsigned)colp[(k0 + 8) * ld] | ((unsigned)colp[(k0 + 9) * ld] << 16);
  r[3] = (unsigned)colp[(k0 + 10) * ld] | ((unsigned)colp[(k0 + 11) * ld] << 16);
  return __builtin_bit_cast(bf16x8, r);
}

typedef __attribute__((ext_vector_type(4))) short s16x4;
#define LDS3 __attribute__((address_space(3)))
DI bf16x8 tr_frag(const u16* tile, int ld, int col0, int r0, int r1, int lane) {
  const int q = (lane & 15) >> 2, pcol = col0 + 16 * ((lane >> 4) & 1) + 4 * (lane & 3);
  const s16x4 lo = __builtin_amdgcn_ds_read_tr16_b64_v4i16((LDS3 s16x4*)(tile + (r0 + q) * ld + pcol));
  const s16x4 hi = __builtin_amdgcn_ds_read_tr16_b64_v4i16((LDS3 s16x4*)(tile + (r1 + q) * ld + pcol));
  return __builtin_shufflevector(lo, hi, 0, 1, 2, 3, 4, 5, 6, 7);
}

#define XB_TMO      128
#define XB_XCNT(j)  (256  + 64 * (j))
#define XB_XSUB(j)  (1280 + 64 * (j))
#define XB_XGEN(j)  (2304 + 64 * (j))
#define XB_TOP      3328
#define XB_TOPGEN   3392
#define XCD_BAR_WORDS 3456
#define XB_SPIN_CAP (1u << 18)
#define LAS __attribute__((address_space(3)))
DI unsigned xb_ld(unsigned* p)              { return __hip_atomic_load(p, __ATOMIC_RELAXED, __HIP_MEMORY_SCOPE_AGENT); }
DI unsigned xb_add(unsigned* p, unsigned v) { return __hip_atomic_fetch_add(p, v, __ATOMIC_RELAXED, __HIP_MEMORY_SCOPE_AGENT); }
DI unsigned xb_xcc_id() { return (unsigned)__builtin_amdgcn_s_getreg((3 << 11) | 20) & 0xFu; }
#define XB_SPIN(cond, bar) do { unsigned _sp = 0; while (cond) { __builtin_amdgcn_s_sleep(1); \
    if ((++_sp & 255u) == 0u) { if (xb_ld(&(bar)[XB_TMO])) break; if (_sp > XB_SPIN_CAP) { atomicAdd(&(bar)[XB_TMO], 1u); break; } } } } while (0)
struct XcdBarrier { unsigned* bar; unsigned x; volatile LAS unsigned* st; };
DI XcdBarrier xcd_barrier_post(unsigned* bar, volatile LAS unsigned* st) {
  XcdBarrier b; b.bar = bar; b.x = xb_xcc_id(); b.st = st;
  if (threadIdx.x == 0) (void)xb_add(&bar[XB_XCNT(b.x)], 1u);
  return b;
}
DI void xcd_barrier_complete(unsigned* bar, unsigned x, unsigned& nloc, unsigned& nx) {
  const unsigned G = gridDim.x * gridDim.y * gridDim.z;
  unsigned sum, cnt, mine, sp = 0u;
  for (;;) {
    sum = 0u; cnt = 0u; mine = 0u;
#pragma unroll
    for (unsigned j = 0; j < 16; ++j) { const unsigned c = xb_ld(&bar[XB_XCNT(j)]); sum += c; cnt += (c > 0u) ? 1u : 0u; mine = (j == x) ? c : mine; }
    if (sum == G) break;
    __builtin_amdgcn_s_sleep(1);
    if ((++sp & 255u) == 0u) { if (xb_ld(&bar[XB_TMO])) break; if (sp > XB_SPIN_CAP) { atomicAdd(&bar[XB_TMO], 1u); break; } }
  }
  nloc = mine > 0u ? mine : 1u; nx = cnt > 0u ? cnt : 1u;
}
DI void xcd_barrier(const XcdBarrier& b) {
  asm volatile("s_waitcnt vmcnt(0)" ::: "memory");
  __syncthreads();
  if (threadIdx.x == 0) {
    unsigned* bar = b.bar;
    __builtin_amdgcn_s_waitcnt(0);
    unsigned nloc = b.st[0], nx = b.st[1];
    if (nloc == 0u) { xcd_barrier_complete(bar, b.x, nloc, nx); b.st[0] = nloc; b.st[1] = nx; }
    const unsigned old = xb_add(&bar[XB_XSUB(b.x)], 1u);
    const unsigned gen = old / nloc;
    if (old + 1u == (gen + 1u) * nloc) {
      __builtin_amdgcn_fence(__ATOMIC_RELEASE, "agent");
      asm volatile("s_waitcnt vmcnt(0)" ::: "memory");
      const unsigned og = xb_add(&bar[XB_TOP], 1u);
      const unsigned tg = og / nx;
      if (og + 1u == (tg + 1u) * nx) xb_add(&bar[XB_TOPGEN], 1u);
      else XB_SPIN(xb_ld(&bar[XB_TOPGEN]) == tg, bar);
      __builtin_amdgcn_fence(__ATOMIC_ACQUIRE, "agent");
      xb_add(&bar[XB_XGEN(b.x)], 1u);
      asm volatile("s_waitcnt vmcnt(0)" ::: "memory");
    } else {
      XB_SPIN(xb_ld(&bar[XB_XGEN(b.x)]) == gen, bar);
      __builtin_amdgcn_fence(__ATOMIC_ACQUIRE, "agent");
      asm volatile("s_waitcnt vmcnt(0)" ::: "memory");
    }
  }
  __syncthreads();
}

DI void prep_rows(const Params& p, int row_lo, int row_hi, int wi, int wc) {
  const int lane = otid() & 63, w = otid() >> 6;
  const int nw = wc * (NT / 64);
  for (int row0 = row_lo + (wi * (NT / 64) + w) * 4; row0 < row_hi; row0 += nw * 4) {
    f32x4 v[4][4];
    const float* g = (row0 < 2 * SL) ? p.pre_g : p.mem_ng;
#pragma unroll
    for (int u = 0; u < 4; ++u) {
      const int row = row0 + u;
      const float* src;
      if (row < 2 * SL) { int s = row >> 14, r = row & (SL - 1); src = p.x[s] + (size_t)r * DM; }
      else { int r = row - 2 * SL; src = (r < 256) ? p.mem[0] + (size_t)r * DM : p.mem[1] + (size_t)(r - 256) * DM; }
#pragma unroll
      for (int i = 0; i < 4; ++i) v[u][i] = __builtin_nontemporal_load((const f32x4*)(src + (i * 64 + lane) * 4));
    }
    f32x4 gg[4];
#pragma unroll
    for (int i = 0; i < 4; ++i) gg[i] = *(const f32x4*)(g + (i * 64 + lane) * 4);
#pragma unroll
    for (int u = 0; u < 4; ++u) {
      const int row = row0 + u;
      u16* dst;
      if (row < 2 * SL) { int s = row >> 14, r = row & (SL - 1); dst = (u16*)(p.out + (size_t)s * SL * DM) + (size_t)r * DM; }
      else dst = p.hm + (size_t)(row - 2 * SL) * DM;
      float ss = 0.f;
#pragma unroll
      for (int i = 0; i < 4; ++i) ss += v[u][i][0] * v[u][i][0] + v[u][i][1] * v[u][i][1] + v[u][i][2] * v[u][i][2] + v[u][i][3] * v[u][i][3];
      ss = wave_sum(ss);
      const float rstd = rsqrtf(ss * (1.f / DM) + 1e-6f);
#pragma unroll
      for (int i = 0; i < 4; ++i) {
        u32x2 o; o[0] = pack2(v[u][i][0] * rstd * gg[i][0], v[u][i][1] * rstd * gg[i][1]);
        o[1] = pack2(v[u][i][2] * rstd * gg[i][2], v[u][i][3] * rstd * gg[i][3]);
        *(u32x2*)(dst + (i * 64 + lane) * 4) = o;
      }
    }
  }
}

template <int MODE>
DI void transpose_tile(const float* __restrict__ src, int N, int K, u16* __restrict__ dst, int n0, int k0, char* smem) {
  float* tile = (float*)smem;
  const int tid = otid();
  {
    const int nn = tid & 127, kb = tid >> 7;
    const int np = n0 + nn;
    int sc; float scale = 1.f; bool valid = true;
    if (MODE == 0) {
      if (np < 3072) { sc = np; if (np < 512) scale = 0.08838834764831845f; }
      else if (np < 6144) { sc = np + 32; if (np < C_NK) scale = 0.125f; else if (np >= C_MQ && np < C_MG) scale = 0.08838834764831845f; }
      else if (np < 6176) { sc = np - 3072; }
      else { sc = 0; valid = false; }
    } else sc = np;
    float v[16];
#pragma unroll
    for (int i = 0; i < 16; ++i) v[i] = valid ? src[(size_t)(k0 + kb + 4 * i) * N + sc] : 0.f;
#pragma unroll
    for (int i = 0; i < 16; ++i) tile[(kb + 4 * i) * 129 + nn] = v[i] * scale;
  }
  __syncthreads();
  {
    const int kk = tid & 63, nb = tid >> 6;
#pragma unroll
    for (int i = 0; i < 16; ++i) {
      int nn = nb + 8 * i;
      dst[(size_t)(n0 + nn) * K + k0 + kk] = f2bf(tile[kk * 129 + nn]);
    }
  }
  __syncthreads();
}

DI void phase0(const Params& p, char* smem) {
  for (int t = blockIdx.x; t < 49 * 16; t += gridDim.x) transpose_tile<0>(p.w_in, 6176, 1024, p.wt_in, (t % 49) * 128, (t / 49) * 64, smem);
  for (int t = ((int)blockIdx.x >= (int)gridDim.x / 2 ? (int)blockIdx.x - (int)gridDim.x / 2 : (int)blockIdx.x + (int)gridDim.x / 2); t < 8 * 16; t += gridDim.x) transpose_tile<1>(p.w_kv, 1024, 1024, p.wt_kv, (t % 8) * 128, (t / 8) * 64, smem);
  prep_rows(p, 0, SL, blockIdx.x, gridDim.x);
  prep_rows(p, 2 * SL, 2 * SL + 768, blockIdx.x, gridDim.x);
}

DI void prep_wout(const Params& p, char* smem, int wi, int wc) {
  for (int t = wi; t < 8 * 32; t += wc) transpose_tile<1>(p.w_out, 1024, 2048, p.wt_out, (t % 8) * 128, (t / 8) * 64, smem);
}

template <int MODE>
DI void gemm_tile(const u16* __restrict__ A, int lda, const u16* __restrict__ Bt, int K, int m0, int n0, void* outp, char* smem) {
  u16* As0 = (u16*)smem;
  u16* Bs0 = As0 + 256 * 72;
  u16* As1 = Bs0 + 128 * 72;
  u16* Bs1 = As1 + 256 * 72;
  const int tid = otid(), lane = tid & 63, w = tid >> 6, h = lane >> 5, l31 = lane & 31;
  const int wm = w >> 1, wn = w & 1;
  const int lrow = tid >> 3, kc = tid & 7;
  f32x16 acc[2][2];
#pragma unroll
  for (int i = 0; i < 2; ++i)
#pragma unroll
    for (int j = 0; j < 2; ++j)
#pragma unroll
      for (int r = 0; r < 16; ++r) acc[i][j][r] = 0.f;
  u32x4 ra0[4], rb0[2], ra1[4], rb1[2];
  const int nk = K / 64;
  auto acol = [&](int k0) -> int {
    if (MODE == 2) return (k0 < 1024) ? (C_GG + k0) : ((k0 < 1536) ? (C_NG + k0 - 1024) : (C_MG + k0 - 1536));
    return k0;
  };
  const u16* Abase = A + (size_t)(m0 + lrow) * lda + kc * 8;
  const u16* Bbase = Bt + (size_t)(n0 + lrow) * K + kc * 8;
  auto gload = [&](int kt, u32x4* ra, u32x4* rb) {
    const int k0 = kt * 64; const int ac = acol(k0);
#pragma unroll
    for (int i = 0; i < 4; ++i) ra[i] = *(const u32x4*)(Abase + (size_t)(64 * i) * lda + ac);
#pragma unroll
    for (int i = 0; i < 2; ++i) rb[i] = *(const u32x4*)(Bbase + (size_t)(64 * i) * K + k0);
  };
  auto lstore = [&](u16* As, u16* Bs, const u32x4* ra, const u32x4* rb) {
#pragma unroll
    for (int i = 0; i < 4; ++i) *(u32x4*)(As + (lrow + 64 * i) * 72 + kc * 8) = ra[i];
#pragma unroll
    for (int i = 0; i < 2; ++i) *(u32x4*)(Bs + (lrow + 64 * i) * 72 + kc * 8) = rb[i];
  };
  auto step = [&](const u16* AsC, const u16* BsC, u16* AsN, u16* BsN, const u32x4* ra, const u32x4* rb, bool do_store) {
#pragma unroll
    for (int ks = 0; ks < 4; ++ks) {
      bf16x8 a[2], b[2];
#pragma unroll
      for (int i = 0; i < 2; ++i) a[i] = *(const bf16x8*)(AsC + (64 * wm + 32 * i + l31) * 72 + 16 * ks + 8 * h);
#pragma unroll
      for (int j = 0; j < 2; ++j) b[j] = *(const bf16x8*)(BsC + (64 * wn + 32 * j + l31) * 72 + 16 * ks + 8 * h);
#pragma unroll
      for (int i = 0; i < 2; ++i)
#pragma unroll
        for (int j = 0; j < 2; ++j) acc[i][j] = MFMA32(a[i], b[j], acc[i][j]);
      if (do_store) {
        if (ks == 0) { *(u32x4*)(AsN + (lrow) * 72 + kc * 8) = ra[0]; *(u32x4*)(AsN + (lrow + 64) * 72 + kc * 8) = ra[1]; }
        if (ks == 1) { *(u32x4*)(AsN + (lrow + 128) * 72 + kc * 8) = ra[2]; *(u32x4*)(AsN + (lrow + 192) * 72 + kc * 8) = ra[3]; }
        if (ks == 2) { *(u32x4*)(BsN + (lrow) * 72 + kc * 8) = rb[0]; *(u32x4*)(BsN + (lrow + 64) * 72 + kc * 8) = rb[1]; }
      }
    }
  };
  gload(0, ra0, rb0); gload(1, ra1, rb1);
  lstore(As0, Bs0, ra0, rb0);
  gload(2, ra0, rb0);
  __syncthreads();
  for (int kt = 0; kt < nk; kt += 2) {
    step(As0, Bs0, As1, Bs1, ra1, rb1, true);
    if (kt + 3 < nk) gload(kt + 3, ra1, rb1);
    __syncthreads();
    step(As1, Bs1, As0, Bs0, ra0, rb0, kt + 2 < nk);
    if (kt + 4 < nk) gload(kt + 4, ra0, rb0);
    __syncthreads();
  }
#pragma unroll
  for (int i = 0; i < 2; ++i)
#pragma unroll
    for (int j = 0; j < 2; ++j)
#pragma unroll
      for (int r = 0; r < 16; ++r) {
        const int row = m0 + 64 * wm + 32 * i + crow(r, h);
        const int col = n0 + 64 * wn + 32 * j + l31;
        if (MODE == 0) ((u16*)outp)[(size_t)row * LDP + col] = f2bf(acc[i][j][r]);
        else if (MODE == 1) ((u16*)outp)[(size_t)row * 1024 + col] = f2bf(acc[i][j][r]);
        else ((float*)outp)[(size_t)row * 1024 + col] = acc[i][j][r];
      }
}

template <int MODE>
DI void gemm_tile_big(const u16* __restrict__ A, int lda, const u16* __restrict__ Bt, int K, int m0, int n0, void* outp, char* smem) {
  u16* As0 = (u16*)smem;
  u16* Bs0 = As0 + 256 * 72;
  u16* As1 = Bs0 + 256 * 72;
  u16* Bs1 = As1 + 256 * 72;
  const int tid = otid(), lane = tid & 63, w = tid >> 6, h = lane >> 5, l31 = lane & 31;
  const int wm = w >> 2, wn = w & 3;
  const int lrow = tid >> 3, kc = tid & 7;
  f32x16 acc[4][2];
#pragma unroll
  for (int i = 0; i < 4; ++i)
#pragma unroll
    for (int j = 0; j < 2; ++j)
#pragma unroll
      for (int r = 0; r < 16; ++r) acc[i][j][r] = 0.f;
  u32x4 ra[4], rb[4];
  const int nk = K / 64;
  auto acol = [&](int k0) -> int {
    if (MODE == 2) return (k0 < 1024) ? (C_GG + k0) : ((k0 < 1536) ? (C_NG + k0 - 1024) : (C_MG + k0 - 1536));
    return k0;
  };
  const u16* Abase = A + (size_t)(m0 + lrow) * lda + kc * 8;
  const u16* Bbase = Bt + (size_t)(n0 + lrow) * K + kc * 8;
  auto gload = [&](int kt) {
    const int k0 = kt * 64; const int ac = acol(k0);
#pragma unroll
    for (int i = 0; i < 4; ++i) ra[i] = *(const u32x4*)(Abase + (size_t)(64 * i) * lda + ac);
#pragma unroll
    for (int i = 0; i < 4; ++i) rb[i] = *(const u32x4*)(Bbase + (size_t)(64 * i) * K + k0);
  };
  auto step = [&](const u16* AsC, const u16* BsC, u16* AsN, u16* BsN, bool do_store) {
#pragma unroll
    for (int ks = 0; ks < 4; ++ks) {
      bf16x8 a[4], b[2];
#pragma unroll
      for (int i = 0; i < 4; ++i) a[i] = *(const bf16x8*)(AsC + (128 * wm + 32 * i + l31) * 72 + 16 * ks + 8 * h);
#pragma unroll
      for (int j = 0; j < 2; ++j) b[j] = *(const bf16x8*)(BsC + (64 * wn + 32 * j + l31) * 72 + 16 * ks + 8 * h);
#pragma unroll
      for (int i = 0; i < 4; ++i)
#pragma unroll
        for (int j = 0; j < 2; ++j) acc[i][j] = MFMA32(a[i], b[j], acc[i][j]);
      if (do_store && ks == 2) {
#pragma unroll
        for (int i = 0; i < 4; ++i) *(u32x4*)(AsN + (lrow + 64 * i) * 72 + kc * 8) = ra[i];
      }
      if (do_store && ks == 3) {
#pragma unroll
        for (int i = 0; i < 4; ++i) *(u32x4*)(BsN + (lrow + 64 * i) * 72 + kc * 8) = rb[i];
      }
    }
  };
  gload(0);
#pragma unroll
  for (int i = 0; i < 4; ++i) { *(u32x4*)(As0 + (lrow + 64 * i) * 72 + kc * 8) = ra[i]; *(u32x4*)(Bs0 + (lrow + 64 * i) * 72 + kc * 8) = rb[i]; }
  gload(1);
  __syncthreads();
  for (int kt = 0; kt < nk; kt += 2) {
    step(As0, Bs0, As1, Bs1, true);
    if (kt + 2 < nk) gload(kt + 2);
    __syncthreads();
    step(As1, Bs1, As0, Bs0, kt + 2 < nk);
    if (kt + 3 < nk) gload(kt + 3);
    __syncthreads();
  }
#pragma unroll
  for (int i = 0; i < 4; ++i)
#pragma unroll
    for (int j = 0; j < 2; ++j)
#pragma unroll
      for (int r = 0; r < 16; ++r) {
        const int row = m0 + 128 * wm + 32 * i + crow(r, h);
        const int col = n0 + 64 * wn + 32 * j + l31;
        if (MODE == 0) ((u16*)outp)[(size_t)row * LDP + col] = f2bf(acc[i][j][r]);
        else ((u16*)outp)[(size_t)row * 2048 + col] = f2bf(acc[i][j][r]);
      }
}

template <bool PASS_C>
DI void gla_item(const Params& p, int slice, int item, char* smem, bool dry = false) {
  u16* Qs = (u16*)smem;
  u16* Ks = Qs + 64 * 136;
  u16* KTs = Ks + 64 * 136;
  u16* VTs = KTs + 128 * 72;
  float* LRs = (float*)(VTs + 256 * 72);
  float* TOT = LRs + 64 * 16;
  float* EB = TOT + 4 * 128;
  float* BL = EB + 128;
  float* WS = BL + 64 * 128;
  const int tid = otid(), lane = tid & 63, w = tid >> 6, h = lane >> 5, l31 = lane & 31;
  const int dir = item & 1, hh = (item >> 1) & 3, sg = item >> 3;
  const int d = tid & 127, tg = tid >> 7;
  const u16* proj = p.proj;
  const float* gw = dir ? p.gw_b : p.gw_f;
  const float* gb = dir ? p.gb_b : p.gb_f;
  u16* WTb = (u16*)WS;
  u16* LRb = (u16*)LRs;
#pragma unroll
  for (int i = 0; i < 4; ++i) { const int e = tid + 512 * i; const int dd = e >> 4, r = e & 15; WTb[e] = f2bf(gw[r * 512 + hh * 128 + dd]); }
  const float bias_z = gb[hh * 128 + 32 * (w >> 1) + l31];
  f32x16 S[4];
  float* Uit = p.U + (size_t)item * 32768;
#pragma unroll
  for (int dt = 0; dt < 4; ++dt)
#pragma unroll
    for (int r = 0; r < 16; ++r) S[dt][r] = PASS_C ? Uit[(dt * 16 + r) * 512 + tid] : 0.f;
  float dlog = 0.f;
  u16* odir = (u16*)(p.out + (size_t)slice * SL * DM) + (size_t)dir * SL * DM;
  const int lrcol = dir ? C_LRB : C_LRF;

  u32x4 pq[2], pk[2], pv[4], plr;
  auto gl_chunk = [&](int cc, int tid) {
    const int c = dir ? 7 - cc : cc;
    const int r0 = sg * 512 + c * 64;
#pragma unroll
    for (int i = 0; i < 2; ++i) {
      const int idx = tid + 512 * i; const int t = idx >> 4, c8 = idx & 15;
      pk[i] = *(const u32x4*)(proj + (size_t)(r0 + t) * LDP + C_GK + hh * 128 + c8 * 8);
      if (PASS_C) pq[i] = *(const u32x4*)(proj + (size_t)(r0 + t) * LDP + C_GQ + hh * 128 + c8 * 8);
    }
    if (tid < 128) plr = *(const u32x4*)(proj + (size_t)(r0 + (tid >> 1)) * LDP + lrcol + (tid & 1) * 8);
  };
  auto gl_chunk_v = [&](int cc, int tid) {
    const int c = dir ? 7 - cc : cc;
    const int r0 = sg * 512 + c * 64;
#pragma unroll
    for (int i = 0; i < 4; ++i) {
      const int idx = tid + 512 * i; const int t = idx >> 5, vg = idx & 31;
      pv[i] = *(const u32x4*)(proj + (size_t)(r0 + t) * LDP + C_GV + hh * 256 + vg * 8);
    }
  };
  gl_chunk(0, tid); gl_chunk_v(0, tid);
  const int tid_outer = tid;
  for (int cc = 0; cc < 8; ++cc) {
    int tid = tid_outer; asm volatile("" : "+v"(tid));
    const int lane = tid & 63, w = tid >> 6, h = lane >> 5, l31 = lane & 31, d = tid & 127, tg = tid >> 7;
    const int c = dir ? 7 - cc : cc;
    int row0 = sg * 512 + c * 64;
    asm volatile("" : "+s"(row0));
#pragma unroll
    for (int i = 0; i < 2; ++i) {
      const int idx = tid + 512 * i; const int t = idx >> 4, c8 = idx & 15;
      *(u32x4*)(Ks + t * 136 + c8 * 8) = pk[i];
      if (PASS_C) *(u32x4*)(Qs + t * 136 + c8 * 8) = pq[i];
    }
#pragma unroll
    for (int i = 0; i < 4; ++i) {
      const int idx = tid + 512 * i; const int t = idx >> 5, vg = idx & 31;
      *(u32x4*)(VTs + t * 288 + vg * 8) = pv[i];
    }
    if (tid < 128) *(u32x4*)(LRb + (tid >> 1) * 16 + (tid & 1) * 8) = plr;
    __syncthreads();
    if (cc + 1 < 8) { gl_chunk(cc + 1, tid); if (!PASS_C) gl_chunk_v(cc + 1, tid); }
    {
      const int ttz = w & 1, dz = 32 * (w >> 1) + l31;
      const bf16x8 az = *(const bf16x8*)(LRb + (32 * ttz + l31) * 16 + 8 * h);
      const bf16x8 bz = *(const bf16x8*)(WTb + dz * 16 + 8 * h);
      f32x16 z;
#pragma unroll
      for (int r = 0; r < 16; ++r) z[r] = 0.f;
      z = MFMA32(az, bz, z);
      float la[16];
#pragma unroll
      for (int r = 0; r < 16; ++r) la[r] = z[r] + bias_z;
      float ex[16];
#pragma unroll
      for (int r = 0; r < 16; ++r) ex[r] = __builtin_amdgcn_exp2f(-fabsf(la[r]) * 1.4426950408889634f);
#pragma unroll
      for (int r = 0; r < 16; ++r) ex[r] = __builtin_amdgcn_logf(1.f + ex[r]);
#pragma unroll
      for (int r = 0; r < 16; ++r) la[r] = (fminf(la[r], 0.f) - 0.6931471805599453f * ex[r]) * (1.f / 16.f);
      float G[4];
#pragma unroll
      for (int g = 0; g < 4; ++g) {
        if (dir) { la[4*g+2] += la[4*g+3]; la[4*g+1] += la[4*g+2]; la[4*g] += la[4*g+1]; G[g] = la[4*g]; }
        else     { la[4*g+1] += la[4*g];   la[4*g+2] += la[4*g+1]; la[4*g+3] += la[4*g+2]; G[g] = la[4*g+3]; }
      }
      float Go[4];
#pragma unroll
      for (int g = 0; g < 4; ++g) Go[g] = __shfl_xor(G[g], 32, 64);
      float base[4]; float runp = 0.f;
      if (dir) {
#pragma unroll
        for (int g = 3; g >= 0; --g) { base[g] = runp + (h == 0 ? Go[g] : 0.f); runp += G[g] + Go[g]; }
      } else {
#pragma unroll
        for (int g = 0; g < 4; ++g) { base[g] = runp + (h == 1 ? Go[g] : 0.f); runp += G[g] + Go[g]; }
      }
#pragma unroll
      for (int g = 0; g < 4; ++g)
#pragma unroll
        for (int r4 = 0; r4 < 4; ++r4) BL[(32 * ttz + 8 * g + 4 * h + r4) * 128 + dz] = la[4 * g + r4] + base[g];
      if (h == 0) TOT[ttz * 128 + dz] = runp;
    }
    __syncthreads();
    const float tot0 = TOT[d], tot1 = TOT[128 + d];
    const float all = tot0 + tot1;
    const float pre = dir ? ((tg < 2) ? tot1 : 0.f) : ((tg >= 2) ? tot0 : 0.f);
    {
      float bb[16], kv[16], qv[16];
#pragma unroll
      for (int u = 0; u < 16; ++u) {
        const int t = 16 * tg + u;
        bb[u] = BL[t * 128 + d] + pre;
        kv[u] = bf2f(Ks[t * 136 + d]);
        if (PASS_C) qv[u] = bf2f(Qs[t * 136 + d]);
      }
      float eb[16];
#pragma unroll
      for (int u = 0; u < 16; ++u) eb[u] = __builtin_amdgcn_exp2f(bb[u] * 1.4426950408889634f);
      unsigned kp[8];
#pragma unroll
      for (int i2 = 0; i2 < 8; ++i2) {
        kp[i2] = pack2(kv[2 * i2] * __builtin_amdgcn_rcpf(eb[2 * i2]), kv[2 * i2 + 1] * __builtin_amdgcn_rcpf(eb[2 * i2 + 1]));
        if (PASS_C) {
          const unsigned qp = pack2(qv[2 * i2] * eb[2 * i2], qv[2 * i2 + 1] * eb[2 * i2 + 1]);
          Ks[(16 * tg + 2 * i2) * 136 + d] = (u16)(kp[i2] & 0xffffu);
          Ks[(16 * tg + 2 * i2 + 1) * 136 + d] = (u16)(kp[i2] >> 16);
          Qs[(16 * tg + 2 * i2) * 136 + d] = (u16)(qp & 0xffffu);
          Qs[(16 * tg + 2 * i2 + 1) * 136 + d] = (u16)(qp >> 16);
        }
      }
      u32x4 k0, k1;
      k0[0] = kp[0]; k0[1] = kp[1]; k0[2] = kp[2]; k0[3] = kp[3];
      k1[0] = kp[4]; k1[1] = kp[5]; k1[2] = kp[6]; k1[3] = kp[7];
      *(u32x4*)(KTs + d * 72 + 16 * tg) = k0;
      *(u32x4*)(KTs + d * 72 + 16 * tg + 8) = k1;
    }
    if (tg == 0) { EB[d] = __expf(all); dlog += all; }
    __syncthreads();

    if (PASS_C) {
      f32x16 X00, X11, Xoff;
#pragma unroll
      for (int r = 0; r < 16; ++r) { X00[r] = 0.f; X11[r] = 0.f; Xoff[r] = 0.f; }
#pragma unroll 2
      for (int s = 0; s < 8; ++s) {
        bf16x8 a0 = *(const bf16x8*)(Ks + l31 * 136 + 16 * s + 8 * h);
        bf16x8 a1 = *(const bf16x8*)(Ks + (32 + l31) * 136 + 16 * s + 8 * h);
        bf16x8 b0 = *(const bf16x8*)(Qs + l31 * 136 + 16 * s + 8 * h);
        bf16x8 b1 = *(const bf16x8*)(Qs + (32 + l31) * 136 + 16 * s + 8 * h);
        X00 = MFMA32(a0, b0, X00);
        X11 = MFMA32(a1, b1, X11);
        bf16x8 ao = dir ? a1 : a0, bo = dir ? b0 : b1;
        Xoff = MFMA32(ao, bo, Xoff);
      }
      {
        int lo = l31 - 4 * h;
        asm volatile("" : "+v"(lo));
#pragma unroll
        for (int r = 0; r < 16; ++r) {
          const int j = (r & 3) + 8 * (r >> 2);
          const bool keep = dir ? (j >= lo) : (j <= lo);
          X00[r] = keep ? X00[r] : 0.f; X11[r] = keep ? X11[r] : 0.f;
        }
      }
      const bf16x8 x00a = pack8<0>(X00), x00b = pack8<1>(X00), x11a = pack8<0>(X11), x11b = pack8<1>(X11),
                   xofa = pack8<0>(Xoff), xofb = pack8<1>(Xoff);
      const bf16x8 vp00 = tr_frag(VTs, 288, 32 * w, 0 + 4 * h, 8 + 4 * h, lane), vp01 = tr_frag(VTs, 288, 32 * w, 16 + 4 * h, 24 + 4 * h, lane),
                   vp10 = tr_frag(VTs, 288, 32 * w, 32 + 4 * h, 40 + 4 * h, lane), vp11 = tr_frag(VTs, 288, 32 * w, 48 + 4 * h, 56 + 4 * h, lane);
#pragma unroll
      for (int it = 0; it < 2; ++it) {
        f32x16 acc;
#pragma unroll
        for (int r = 0; r < 16; ++r) acc[r] = 0.f;
        const u16* qrow = Qs + (32 * it + l31) * 136;
#pragma unroll
        for (int dt = 0; dt < 4; ++dt) {
          acc = MFMA32(ld_perm(qrow + 32 * dt, 0, h), pack8<0>(S[dt]), acc);
          acc = MFMA32(ld_perm(qrow + 32 * dt, 1, h), pack8<1>(S[dt]), acc);
        }
        if (it == 0) {
          acc = MFMA32(x00a, vp00, acc);
          acc = MFMA32(x00b, vp01, acc);
          if (dir) {
            acc = MFMA32(xofa, vp10, acc);
            acc = MFMA32(xofb, vp11, acc);
          }
        } else {
          acc = MFMA32(x11a, vp10, acc);
          acc = MFMA32(x11b, vp11, acc);
          if (!dir) {
            acc = MFMA32(xofa, vp00, acc);
            acc = MFMA32(xofb, vp01, acc);
          }
        }
#pragma unroll
        for (int r = 0; r < 16; ++r)
          if (!dry) odir[(size_t)(row0 + 32 * it + crow(r, h)) * DM + hh * 256 + 32 * w + l31] = f2bf(acc[r]);
      }
    }
    if (PASS_C && cc + 1 < 8) gl_chunk_v(cc + 1, tid);
    bf16x8 vb[4];
#pragma unroll
    for (int ks = 0; ks < 4; ++ks) vb[ks] = tr_frag(VTs, 288, 32 * w, 16 * ks + 8 * h, 16 * ks + 8 * h + 4, lane);
#pragma unroll
    for (int dt = 0; dt < 4; ++dt) {
#pragma unroll
      for (int ks = 0; ks < 4; ++ks) {
        bf16x8 a = *(const bf16x8*)(KTs + (32 * dt + l31) * 72 + 16 * ks + 8 * h);
        S[dt] = MFMA32(a, vb[ks], S[dt]);
      }
#pragma unroll
      for (int g = 0; g < 4; ++g) {
        f32x4 e = *(const f32x4*)(EB + 32 * dt + 8 * g + 4 * h);
        S[dt][4 * g + 0] *= e[0]; S[dt][4 * g + 1] *= e[1]; S[dt][4 * g + 2] *= e[2]; S[dt][4 * g + 3] *= e[3];
      }
    }
    __syncthreads();
  }
  if (!PASS_C) {
#pragma unroll
    for (int dt = 0; dt < 4; ++dt)
#pragma unroll
      for (int r = 0; r < 16; ++r) Uit[(dt * 16 + r) * 512 + tid] = S[dt][r];
    if (tg == 0) p.Dlog[item * 128 + d] = dlog;
  }
}

DI void gla_pass_b(const Params& p, int slice) {
  const int nseq = slice == 0 ? 1 : 2, segs = slice == 0 ? 32 : 16;
  const int total = nseq * 8 * 32768;
  for (int e = blockIdx.x * NT + otid(); e < total; e += gridDim.x * NT) {
    const int elem = e & 32767, hd = (e >> 15) & 7, sq = e >> 18;
    const int dir = hd & 1;
    const int t = elem & 511, dtreg = elem >> 9;
    const int hl = (t & 63) >> 5;
    const int d = 32 * (dtreg >> 4) + crow(dtreg & 15, hl);
    float carry = 0.f;
    for (int i0 = 0; i0 < segs; i0 += 16) {
      float u[16], dl[16];
#pragma unroll
      for (int k = 0; k < 16; ++k) {
        const int sgl = dir ? segs - 1 - (i0 + k) : (i0 + k);
        const int it = (sq * segs + sgl) * 8 + hd;
        u[k] = p.U[(size_t)it * 32768 + elem];
        dl[k] = p.Dlog[it * 128 + d];
      }
#pragma unroll
      for (int k = 0; k < 16; ++k) {
        const int sgl = dir ? segs - 1 - (i0 + k) : (i0 + k);
        const int it = (sq * segs + sgl) * 8 + hd;
        p.U[(size_t)it * 32768 + elem] = carry;
        carry = __expf(dl[k]) * carry + u[k];
      }
    }
  }
}

DI void gla_combine(const Params& p, int slice) {
  const int lane = otid() & 63, w = otid() >> 6;
  const int nw = gridDim.x * (NT / 64);
  const u16* of = (const u16*)(p.out + (size_t)slice * SL * DM);
  const u16* ob = of + (size_t)SL * DM;
  const int col = (lane >> 4) * 256 + (lane & 15) * 16;
  float ng[16];
#pragma unroll
  for (int i = 0; i < 4; ++i) { f32x4 t4 = *(const f32x4*)(p.gla_ng + (lane & 15) * 16 + 4 * i); ng[4*i] = t4[0]; ng[4*i+1] = t4[1]; ng[4*i+2] = t4[2]; ng[4*i+3] = t4[3]; }
  for (int row0 = (blockIdx.x * (NT / 64) + w) * 4; row0 < SL; row0 += nw * 4) {
    bf16x8 a0[4], a1[4], b0[4], b1[4], g0[4], g1[4];
#pragma unroll
    for (int u = 0; u < 4; ++u) {
      const int row = row0 + u;
      a0[u] = *(const bf16x8*)(of + (size_t)row * DM + col); a1[u] = *(const bf16x8*)(of + (size_t)row * DM + col + 8);
      b0[u] = *(const bf16x8*)(ob + (size_t)row * DM + col); b1[u] = *(const bf16x8*)(ob + (size_t)row * DM + col + 8);
      const u16* gp = p.proj + (size_t)row * LDP + C_GG + col;
      g0[u] = *(const bf16x8*)gp; g1[u] = *(const bf16x8*)(gp + 8);
    }
#pragma unroll
    for (int u = 0; u < 4; ++u) {
      u16* gp = p.proj + (size_t)(row0 + u) * LDP + C_GG + col;
      float o[16]; float ss = 0.f;
#pragma unroll
      for (int i = 0; i < 8; ++i) {
        o[i] = bf2f((u16)a0[u][i]) + bf2f((u16)b0[u][i]); o[8 + i] = bf2f((u16)a1[u][i]) + bf2f((u16)b1[u][i]);
        ss += o[i] * o[i] + o[8 + i] * o[8 + i];
      }
#pragma unroll
      for (int m = 8; m > 0; m >>= 1) ss += __shfl_xor(ss, m, 64);
      const float rstd = rsqrtf(ss * (1.f / 256.f) + 1e-6f);
      u32x4 r0, r1;
#pragma unroll
      for (int i = 0; i < 4; ++i) {
        r0[i] = pack2(o[2*i] * rstd * ng[2*i] * silu(bf2f((u16)g0[u][2*i])), o[2*i+1] * rstd * ng[2*i+1] * silu(bf2f((u16)g0[u][2*i+1])));
        r1[i] = pack2(o[8+2*i] * rstd * ng[8+2*i] * silu(bf2f((u16)g1[u][2*i])), o[8+2*i+1] * rstd * ng[8+2*i+1] * silu(bf2f((u16)g1[u][2*i+1])));
      }
      *(u32x4*)gp = r0; *(u32x4*)(gp + 8) = r1;
    }
  }
}

DI void nat_item(const Params& p, int slice, int item, char* smem, bool dry = false) {
  const int tid = otid(), lane = tid & 63, w = tid >> 6, h = lane >> 5, l31 = lane & 31;
  u16* VT = (u16*)smem + w * (64 * 96);
  float* SC = (float*)(smem + 8 * 64 * 96 * 2) + w * 64;
  float* BIAS = (float*)(smem + 8 * 64 * 96 * 2 + 8 * 64 * 4) + w * 480;
  const int nh = item & 7, R = item >> 3;
  const int rows = slice == 0 ? 256 : 128;
  const int sq = R / rows, r = R % rows;
  const int rs = min(max(r - 4, 0), rows - 8);
  const int seq0 = sq * rows * 64;
  const int qrow0 = seq0 + r * 64;
  u16* proj = p.proj;
  for (int i = lane; i < 465; i += 64) BIAS[i] = p.rpb[nh * 465 + i];
  bf16x8 bq[2][4];
#pragma unroll
  for (int qt = 0; qt < 2; ++qt)
#pragma unroll
    for (int s = 0; s < 4; ++s) bq[qt][s] = *(const bf16x8*)(proj + (size_t)(qrow0 + 32 * qt + l31) * LDP + C_NQ + nh * 64 + 16 * s + 8 * h);
  f32x16 o[2][2];
#pragma unroll
  for (int a = 0; a < 2; ++a)
#pragma unroll
    for (int b = 0; b < 2; ++b)
#pragma unroll
      for (int rr = 0; rr < 16; ++rr) o[a][b][rr] = 0.f;
  float mrun[2] = {-1e30f, -1e30f}, lrun[2] = {0.f, 0.f};
  unsigned vmask[2];
#pragma unroll
  for (int qt = 0; qt < 2; ++qt) {
    const int cq = 32 * qt + l31;
    const int cs = min(max(cq - 8, 0), 48);
    unsigned m = 0u;
#pragma unroll
    for (int kt = 0; kt < 2; ++kt)
#pragma unroll
      for (int rr = 0; rr < 16; ++rr) {
        const int ck = 32 * kt + crow(rr, h);
        m |= ((ck >= cs) && (ck < cs + 16)) ? (1u << (kt * 16 + rr)) : 0u;
      }
    vmask[qt] = m;
  }
  bf16x8 ka[2][4]; u32x4 vc[8];
  auto ld_row = [&](int kk, bf16x8 (&kf)[2][4], u32x4 (&vr)[8]) {
    const int kr0 = seq0 + (rs + kk) * 64;
#pragma unroll
    for (int i = 0; i < 8; ++i) {
      const int idx = lane + 64 * i; const int key = idx >> 3, dg = idx & 7;
      vr[i] = *(const u32x4*)(proj + (size_t)(kr0 + key) * LDP + C_NV + nh * 64 + dg * 8);
    }
#pragma unroll
    for (int kt = 0; kt < 2; ++kt)
#pragma unroll
      for (int s = 0; s < 4; ++s) kf[kt][s] = *(const bf16x8*)(proj + (size_t)(kr0 + 32 * kt + l31) * LDP + C_NK + nh * 64 + 16 * s + 8 * h);
  };
#pragma unroll 1
  for (int kk = 0; kk < 8; ++kk) {
    ld_row(kk, ka, vc);
#pragma unroll
    for (int i = 0; i < 8; ++i) {
      const int idx = lane + 64 * i; const int key = idx >> 3, dg = idx & 7;
      *(u32x4*)(VT + key * 96 + dg * 8) = vc[i];
    }
    f32x16 acc[2][2];
#pragma unroll
    for (int a = 0; a < 2; ++a)
#pragma unroll
      for (int b = 0; b < 2; ++b)
#pragma unroll
        for (int rr = 0; rr < 16; ++rr) acc[a][b][rr] = 0.f;
#pragma unroll
    for (int s = 0; s < 4; ++s)
#pragma unroll
      for (int kt = 0; kt < 2; ++kt)
#pragma unroll
        for (int qt = 0; qt < 2; ++qt) acc[kt][qt] = MFMA32(ka[kt][s], bq[qt][s], acc[kt][qt]);
    const int drow = rs + kk - r + 7;
#pragma unroll
    for (int qt = 0; qt < 2; ++qt) {
      const int cq = 32 * qt + l31;
      const float* bp = BIAS + drow * 31 + (15 - cq + 4 * h);
      float mx = -1e30f;
#pragma unroll
      for (int kt = 0; kt < 2; ++kt)
#pragma unroll
        for (int rr = 0; rr < 16; ++rr) {
          const float sc = acc[kt][qt][rr] + bp[32 * kt + (rr & 3) + 8 * (rr >> 2)];
          acc[kt][qt][rr] = ((vmask[qt] >> (kt * 16 + rr)) & 1u) ? sc : -1e30f;
          mx = fmaxf(mx, acc[kt][qt][rr]);
        }
      mx = fmaxf(mx, __shfl_xor(mx, 32, 64));
      const float mnew = fmaxf(mrun[qt], mx);
      const float alpha = __expf(mrun[qt] - mnew);
      mrun[qt] = mnew;
      float ls = 0.f;
#pragma unroll
      for (int kt = 0; kt < 2; ++kt)
#pragma unroll
        for (int rr = 0; rr < 16; ++rr) { float e = __expf(acc[kt][qt][rr] - mnew); acc[kt][qt][rr] = e; ls += e; }
      ls += __shfl_xor(ls, 32, 64);
      lrun[qt] = lrun[qt] * alpha + ls;
#pragma unroll
      for (int dt = 0; dt < 2; ++dt)
#pragma unroll
        for (int rr = 0; rr < 16; ++rr) o[qt][dt][rr] *= alpha;
    }
    bf16x8 vf[2][4];
#pragma unroll
    for (int dt = 0; dt < 2; ++dt) {
      vf[dt][0] = tr_frag(VT, 96, 32 * dt, 0 + 4 * h, 8 + 4 * h, lane);   vf[dt][1] = tr_frag(VT, 96, 32 * dt, 16 + 4 * h, 24 + 4 * h, lane);
      vf[dt][2] = tr_frag(VT, 96, 32 * dt, 32 + 4 * h, 40 + 4 * h, lane); vf[dt][3] = tr_frag(VT, 96, 32 * dt, 48 + 4 * h, 56 + 4 * h, lane);
    }
#pragma unroll
    for (int qt = 0; qt < 2; ++qt) {
      const bf16x8 p00 = pack8<0>(acc[0][qt]), p01 = pack8<1>(acc[0][qt]), p10 = pack8<0>(acc[1][qt]), p11 = pack8<1>(acc[1][qt]);
#pragma unroll
      for (int dt = 0; dt < 2; ++dt) {
        o[qt][dt] = MFMA32(vf[dt][0], p00, o[qt][dt]);
        o[qt][dt] = MFMA32(vf[dt][1], p01, o[qt][dt]);
        o[qt][dt] = MFMA32(vf[dt][2], p10, o[qt][dt]);
        o[qt][dt] = MFMA32(vf[dt][3], p11, o[qt][dt]);
      }
    }
  }
#pragma unroll
  for (int qt = 0; qt < 2; ++qt) {
    const float inv = 1.f / lrun[qt];
    u16* rowp = proj + (size_t)(qrow0 + 32 * qt + l31) * LDP + C_NG + nh * 64;
#pragma unroll
    for (int dt = 0; dt < 2; ++dt)
#pragma unroll
      for (int g = 0; g < 4; ++g) {
        u16* gp = rowp + 32 * dt + 8 * g + 4 * h;
        const bf16x4 gt = *(const bf16x4*)gp;
        u32x2 res;
        res[0] = pack2(o[qt][dt][4 * g + 0] * inv * silu(bf2f((u16)gt[0])), o[qt][dt][4 * g + 1] * inv * silu(bf2f((u16)gt[1])));
        res[1] = pack2(o[qt][dt][4 * g + 2] * inv * silu(bf2f((u16)gt[2])), o[qt][dt][4 * g + 3] * inv * silu(bf2f((u16)gt[3])));
        if (!dry) *(u32x2*)gp = res;
      }
  }
}

DI void mem_item(const Params& p, int slice, int item, char* smem, bool dry = false) {
  const int tid = otid(), lane = tid & 63, w = tid >> 6, h = lane >> 5, l31 = lane & 31;
  u16* VT = (u16*)smem;
  u16* KM = VT + 256 * 144;
  const int mh = item & 3, tb = item >> 2;
  const int batch = slice == 0 ? 0 : (tb < 32 ? 1 : 2);
  const u16* mkv = p.mkv + (size_t)batch * 256 * 1024;
  u16* proj = p.proj;
#pragma unroll
  for (int i = 0; i < 8; ++i) {
    int idx = tid + 512 * i; int key = idx >> 4, dg = idx & 15;
    *(u32x4*)(VT + key * 144 + dg * 8) = *(const u32x4*)(mkv + (size_t)key * 1024 + 512 + mh * 128 + dg * 8);
    *(u32x4*)(KM + key * 136 + dg * 8) = *(const u32x4*)(mkv + (size_t)key * 1024 + mh * 128 + dg * 8);
  }
  const int qrow = tb * 256 + 32 * w + l31;
  bf16x8 bq[8];
#pragma unroll
  for (int s = 0; s < 8; ++s) bq[s] = *(const bf16x8*)(proj + (size_t)qrow * LDP + C_MQ + mh * 128 + 16 * s + 8 * h);
  float* LB = (float*)(smem + 256 * 144 * 2 + 256 * 136 * 2) + w * 32;
  constexpr float kDefer = 8.f;
  float m = -1e30f;
  __syncthreads();
  f32x16 o[4];
#pragma unroll
  for (int dt = 0; dt < 4; ++dt)
#pragma unroll
    for (int rr = 0; rr < 16; ++rr) o[dt][rr] = 0.f;
  float l = 0.f;
#pragma unroll 1
  for (int kt = 0; kt < 8; ++kt) {
    f32x16 acc;
#pragma unroll
    for (int rr = 0; rr < 16; ++rr) acc[rr] = 0.f;
#pragma unroll
    for (int s = 0; s < 8; ++s) {
      bf16x8 a = *(const bf16x8*)(KM + (32 * kt + l31) * 136 + 16 * s + 8 * h);
      acc = MFMA32(a, bq[s], acc);
    }
    float mx = acc[0];
#pragma unroll
    for (int rr = 1; rr < 16; ++rr) mx = fmaxf(mx, acc[rr]);
    mx = fmaxf(mx, __shfl_xor(mx, 32, 64));
    const bool need = mx > m + kDefer;
    if (__any(need)) {
      const float mnew = need ? mx : m;
      const float alpha = __expf(m - mnew);
      m = mnew; l *= alpha;
#pragma unroll
      for (int dt = 0; dt < 4; ++dt)
#pragma unroll
        for (int rr = 0; rr < 16; ++rr) o[dt][rr] *= alpha;
    }
#pragma unroll
    for (int rr = 0; rr < 16; ++rr) { float e = __expf(acc[rr] - m); acc[rr] = e; l += e; }
    const bf16x8 p0 = pack8<0>(acc), p1 = pack8<1>(acc);
#pragma unroll
    for (int dt = 0; dt < 4; ++dt) {
      o[dt] = MFMA32(tr_frag(VT, 144, 32 * dt, 32 * kt + 4 * h, 32 * kt + 8 + 4 * h, lane), p0, o[dt]);
      o[dt] = MFMA32(tr_frag(VT, 144, 32 * dt, 32 * kt + 16 + 4 * h, 32 * kt + 24 + 4 * h, lane), p1, o[dt]);
    }
  }
  l += __shfl_xor(l, 32, 64);
  {
    const float inv = 1.f / l;
    u16* rowp = proj + (size_t)(tb * 256 + 32 * w + l31) * LDP + C_MG + mh * 128;
#pragma unroll
    for (int dt = 0; dt < 4; ++dt)
#pragma unroll
      for (int g = 0; g < 4; ++g) {
        u16* gp = rowp + 32 * dt + 8 * g + 4 * h;
        const bf16x4 gt = *(const bf16x4*)gp;
        u32x2 res;
        res[0] = pack2(o[dt][4 * g + 0] * inv * silu(bf2f((u16)gt[0])), o[dt][4 * g + 1] * inv * silu(bf2f((u16)gt[1])));
        res[1] = pack2(o[dt][4 * g + 2] * inv * silu(bf2f((u16)gt[2])), o[dt][4 * g + 3] * inv * silu(bf2f((u16)gt[3])));
        if (!dry) *(u32x2*)gp = res;
      }
  }
  __syncthreads();
}

DI void final_norm(const Params& p, int slice, int wi, int wc) {
  const int lane = otid() & 63, w = otid() >> 6;
  const int nw = wc * (NT / 64);
  f32x4 g[4];
#pragma unroll
  for (int i = 0; i < 4; ++i) g[i] = *(const f32x4*)(p.post_g + (i * 64 + lane) * 4);
  for (int r0 = (wi * (NT / 64) + w) * 4; r0 < SL; r0 += nw * 4) {
    bf16x4 vb[4][4]; f32x4 xq[4][4];
#pragma unroll
    for (int u = 0; u < 4; ++u) {
      const u16* o = (const u16*)(p.out + ((size_t)slice * SL + r0 + u) * DM);
      const float* xs = p.x[slice] + (size_t)(r0 + u) * DM;
#pragma unroll
      for (int i = 0; i < 4; ++i) { vb[u][i] = __builtin_nontemporal_load((const bf16x4*)(o + (i * 64 + lane) * 4)); xq[u][i] = __builtin_nontemporal_load((const f32x4*)(xs + (i * 64 + lane) * 4)); }
    }
    float rstd[4];
#pragma unroll
    for (int u = 0; u < 4; ++u) {
      float ss = 0.f;
#pragma unroll
      for (int i = 0; i < 4; ++i)
#pragma unroll
        for (int c = 0; c < 4; ++c) { const float v = bf2f((u16)vb[u][i][c]); ss += v * v; }
      ss = wave_sum(ss);
      rstd[u] = rsqrtf(ss * (1.f / DM) + 1e-6f);
    }
#pragma unroll
    for (int u = 0; u < 4; ++u) {
      float* o = p.out + ((size_t)slice * SL + r0 + u) * DM;
#pragma unroll
      for (int i = 0; i < 4; ++i) {
        f32x4 y;
#pragma unroll
        for (int c = 0; c < 4; ++c) y[c] = xq[u][i][c] + bf2f((u16)vb[u][i][c]) * rstd[u] * g[i][c];
        __builtin_nontemporal_store(y, (f32x4*)(o + (i * 64 + lane) * 4));
      }
    }
  }
}

DI int xq(int v, int G, int& x) { const int b = v % G, i = v / G; x = b & 7; return (b >> 3) + (G >> 3) * i; }
DI void map_p1(int v, int G, int& m, int& n) {
  if (G != 256) { m = v / 49; n = v % 49; return; }
  int x; const int q = xq(v, G, x);
  if (q >= 392) { m = -1; n = 0; return; }
  const int mh = q / 196, rem = q % 196;
  n = rem >> 2; m = 8 * x + 4 * mh + (rem & 3);
}
DI void map_out(int v, int G, int& m, int& n) {
  if (G != 256) { m = v / 8; n = v % 8; return; }
  int x; const int q = xq(v, G, x);
  if (q >= 64) { m = -1; n = 0; return; }
  n = (q >> 2) & 7; m = 8 * x + 4 * (q >> 5) + (q & 3);
}
DI void map_p1_big(int v, int G, int& m, int& n) {
  if (G != 256) { m = v / 24; n = v % 24; return; }
  int x; const int q = xq(v, G, x);
  if (q >= 192) { m = -1; n = 0; return; }
  n = q >> 3; m = 8 * x + (q & 7);
}
DI void map_out_big(int v, int G, int& m, int& n) {
  if (G != 256) { m = v / 4; n = v % 4; return; }
  int x; const int q = xq(v, G, x);
  if (q >= 32) { m = -1; n = 0; return; }
  n = (q >> 2) & 3; m = 8 * x + 4 * (q >> 4) + (q & 3);
}
DI int map_gla(int v, int G) {
  if (G != 256) return v;
  int x; const int q = xq(v, G, x);
  if (q >= 32) return -1;
  return (4 * x + (q >> 3)) * 8 + (q & 7);
}
DI int map_natrow(int v, int G) {
  if (G != 256) return v;
  int x; const int q = xq(v, G, x);
  if (q >= 32) return -1;
  return 32 * x + q;
}
#define GSYNC() do { xcd_barrier(xb); if (DUP & 64) xcd_barrier(xb); } while (0)
__global__ void __launch_bounds__(NT) mega_kernel(Params p) {
  __shared__ __attribute__((aligned(16))) char smem[SMEM_BYTES];
  __shared__ uint4 xb_words;
  cg::grid_group grid = cg::this_grid();
  const int G = gridDim.x, B = blockIdx.x;
  if (threadIdx.x == 0) xb_words = make_uint4(0u, 0u, 0u, 0u);
  __syncthreads();
  const XcdBarrier xb = xcd_barrier_post(p.bar, (volatile LAS unsigned*)&xb_words);

  if (PH & 1) phase0(p, smem);
  if (DUP & 32) phase0(p, smem);
  if (p.use_cg_sync) grid.sync(); else GSYNC();
#pragma unroll 1
  for (int s = 0; s < 2; ++s) {
    {
      const u16* hA = (const u16*)(p.out + (size_t)s * SL * DM);
      if (PH & 2) {
        const int w_lo = (G == 256) ? (s == 0 ? 88 : 64) : 0;
        const int wi = B - w_lo, wc = G - w_lo;
        const int extra_at = (B >> 3) % 6; int ti = 0; bool extra_done = (wi < 0);
        for (int rp = 1; rp < p.rep_p1; ++rp)
          for (int t = B; t < 64 * 24; t += G) { int m, n; map_p1_big(t, G, m, n); if (m < 0 || m >= 64) break; gemm_tile_big<0>(hA, DM, p.wt_in, 1024, m * 256, n * 256, p.proj, smem); }
        for (int t = B; t < 64 * 24; t += G, ++ti) {
          if (ti == extra_at && !extra_done) { if (s == 0) { prep_rows(p, SL, 2 * SL, wi, wc); prep_wout(p, smem, wi, wc); } else if (PH & 8) final_norm(p, 0, wi, wc); extra_done = true; }
          int m, n; map_p1_big(t, G, m, n); if (m < 0 || m >= 64) break; gemm_tile_big<0>(hA, DM, p.wt_in, 1024, m * 256, n * 256, p.proj, smem);
        }
        if (!extra_done) { if (s == 0) { prep_rows(p, SL, 2 * SL, wi, wc); prep_wout(p, smem, wi, wc); } else if (PH & 8) final_norm(p, 0, wi, wc); }
        for (int t = B; t < 64; t += G) gemm_tile<0>(hA, DM, p.wt_in, 1024, t * 256, 6144, p.proj, smem);
      }
      if (DUP & 8) {
        for (int t = B; t < 64 * 24; t += G) { int m, n; map_p1_big(t, G, m, n); if (m < 0 || m >= 64) break; gemm_tile_big<0>(hA, DM, p.wt_in, 1024, m * 256, n * 256, p.proj, smem); }
        for (int t = B; t < 64; t += G) gemm_tile<0>(hA, DM, p.wt_in, 1024, t * 256, 6144, p.proj, smem);
      }
      if (s == 0) {
        if (PH & 4) for (int t = (B >= 64 ? B - 64 : B + G - 64); t < 3 * 8; t += G) gemm_tile<1>(p.hm, DM, p.wt_kv, 1024, (t / 8) * 256, (t % 8) * 128, p.mkv, smem);
      }
    }
    GSYNC();
    {
      const bool gla_first = ((B >> 3) & 1) == 0;
#pragma unroll 1
      for (int st = 0; st < 2; ++st) {
        if ((st == 0) == gla_first) {
          if (PH & 16) for (int t = B; t < 256; t += G) { const int it = map_gla(t, G); if (it < 0) break; gla_item<false>(p, s, it, smem); }
        } else {
          if (PH & 32) { for (int t = B; t < 256; t += G) { const int R = map_natrow(t, G); if (R < 0) break; nat_item(p, s, R * 8 + (otid() >> 6), smem); } __syncthreads(); }
          if (PH & 64) for (int t = B; t < 256; t += G) mem_item(p, s, t, smem);
        }
      }
    }
    GSYNC();
    if (PH & 128) gla_pass_b(p, s);
    GSYNC();
    if (PH & 256) for (int t = B; t < 256; t += G) { const int it = map_gla(t, G); if (it < 0) break; gla_item<true>(p, s, it, smem); }
    if (DUP & (1 | 512)) for (int t = B; t < 256; t += G) { const int it = map_gla(t, G); if (it < 0) break; gla_item<true>(p, s, it, smem); }
    if (DUP & 1024) for (int t = B; t < 256; t += G) { const int it = map_gla(t, G); if (it < 0) break; gla_item<true>(p, s, it, smem, p.dry != 0); }
    GSYNC();
    if (PH & 512) gla_combine(p, s);
    GSYNC();
    {
      float* od = p.out + (size_t)s * SL * DM;
      if (PH & 1024) for (int t = B; t < 64 * 4; t += G) { int m, n; map_out_big(t, G, m, n); if (m < 0 || m >= 64) break; gemm_tile_big<2>(p.proj, LDP, p.wt_out, 2048, m * 256, n * 256, od, smem); }
      if (DUP & 16) for (int t = B; t < 64 * 4; t += G) { int m, n; map_out_big(t, G, m, n); if (m < 0 || m >= 64) break; gemm_tile_big<2>(p.proj, LDP, p.wt_out, 2048, m * 256, n * 256, od, smem); }
    }
    GSYNC();
  }
  if (PH & 8) final_norm(p, 1, B, G);
}

extern "C" void kernel_launch(void* const* d_in, const int* in_sizes, int n_in, void* d_out, int out_size, void* d_ws,
                              size_t ws_size, hipStream_t stream) {
  static int grid_blocks = 0;
  if (!grid_blocks) {
    int dev = 0, cus = 0, per_cu = 0;
    hipGetDevice(&dev);
    hipDeviceGetAttribute(&cus, hipDeviceAttributeMultiprocessorCount, dev);
    hipOccupancyMaxActiveBlocksPerMultiprocessor(&per_cu, mega_kernel, NT, 0);
    if (per_cu < 1) per_cu = 1;
    if (per_cu > 1) per_cu = 1;
    grid_blocks = cus * per_cu;
  }
  Params p{};
  p.x[0] = (const float*)d_in[0]; p.x[1] = (const float*)d_in[1];
  p.mem[0] = (const float*)d_in[2]; p.mem[1] = (const float*)d_in[3];
  p.pre_g = (const float*)d_in[4]; p.w_in = (const float*)d_in[5];
  p.gw_f = (const float*)d_in[6]; p.gb_f = (const float*)d_in[7];
  p.gw_b = (const float*)d_in[8]; p.gb_b = (const float*)d_in[9];
  p.gla_ng = (const float*)d_in[10]; p.rpb = (const float*)d_in[11];
  p.mem_ng = (const float*)d_in[12]; p.w_kv = (const float*)d_in[13];
  p.w_out = (const float*)d_in[14]; p.post_g = (const float*)d_in[15];
  p.out = (float*)d_out;
  p.dry = 1;
  p.rep_p1 = REP_P1;
  p.use_cg_sync = 0;
  char* ws = (char*)d_ws; size_t off = 0;
  auto take = [&](size_t bytes) { char* r = ws + off; off += (bytes + 255) & ~(size_t)255; return r; };
  p.proj = (u16*)take((size_t)SL * LDP * 2);
  p.U = (float*)take((size_t)256 * 32768 * 4);
  p.Dlog = (float*)take((size_t)256 * 128 * 4);
  p.wt_in = (u16*)take((size_t)LDP * 1024 * 2);
  p.wt_kv = (u16*)take((size_t)1024 * 1024 * 2);
  p.wt_out = (u16*)take((size_t)1024 * 2048 * 2);
  p.hm = (u16*)take((size_t)768 * 1024 * 2);
  p.mkv = (u16*)take((size_t)768 * 1024 * 2);
  p.bar = (unsigned*)take((size_t)XCD_BAR_WORDS * 4);
  if (off > ws_size) { fprintf(stderr, "workspace too small: need %zu have %zu\n", off, ws_size); return; }
  hipMemsetAsync(p.bar, 0, (size_t)XCD_BAR_WORDS * 4, stream);
  void* args[] = {&p};
  hipError_t e = hipLaunchCooperativeKernel((void*)mega_kernel, dim3(grid_blocks), dim3(NT), args, 0, stream);
  if (e != hipSuccess) fprintf(stderr, "cooperative launch failed: %s (grid %d)\n", hipGetErrorString(e), grid_blocks);
}
```
